# Optimizing an MI355X kernel written in HIP

```python
import jax
import jax.numpy as jnp
from jax import lax
import numpy as np

D_MODEL = 1024
BATCH = 8
SEQ = 4096
DEPTH = 4

N_EVEN = (DEPTH + 1) // 2
N_ODD = DEPTH // 2
D_FF = 4 * D_MODEL
NORM_EPS = 1e-6

SC_WIDTH = D_MODEL // 2
SC_KERNEL = 3
MLA_HEADS = 8
MLA_NOPE = 64
MLA_ROPE = 32
MLA_V = 64
MLA_Q_RANK = 384
MLA_KV_RANK = 256
ROPE_THETA = 10000.0
ATTN_BLOCK = 128
EVEN_SPLITS = (SC_WIDTH, SC_WIDTH, SC_WIDTH, MLA_Q_RANK, MLA_KV_RANK, MLA_ROPE)
EVEN_IN = sum(EVEN_SPLITS)
EVEN_MIX = SC_WIDTH + MLA_HEADS * MLA_V

GLA_HEADS = 4
GLA_DK = 64
GLA_DV = 128
GLA_GATE_RANK = 16
GLA_TAU = 16.0
GLA_CHUNK = 64
LRU_WIDTH = D_MODEL // 2
LRU_BLOCKS = 8
LRU_KERNEL = 4
LRU_C = 8.0
ODD_SPLITS = (GLA_HEADS * GLA_DK, GLA_HEADS * GLA_DK, GLA_HEADS * GLA_DV, GLA_GATE_RANK,
              GLA_HEADS * GLA_DV, LRU_WIDTH, LRU_WIDTH)
ODD_IN = sum(ODD_SPLITS)
ODD_MIX = GLA_HEADS * GLA_DV + LRU_WIDTH

kernel_name = 'hybrid_sconv_mla_gla_rglru_trunk'


def _split(t, sizes):
    return jnp.split(t, np.cumsum(sizes)[:-1].tolist(), axis=-1)


def rmsnorm(x, g):
    xf = x.astype(jnp.float32)
    y = xf * lax.rsqrt(jnp.mean(xf * xf, axis=-1, keepdims=True) + NORM_EPS)
    return (y * g.astype(jnp.float32)).astype(x.dtype)


def causal_dwconv(u, w):
    k = w.shape[0]
    return lax.conv_general_dilated(
        u, w[:, None, :].astype(u.dtype), window_strides=(1,), padding=[(k - 1, 0)],
        dimension_numbers=('NWC', 'WIO', 'NWC'), feature_group_count=u.shape[-1])


def apply_rope(x, cos, sin):
    half = x.shape[-1] // 2
    x1, x2 = x[..., :half], x[..., half:]
    return jnp.concatenate([x1 * cos - x2 * sin, x2 * cos + x1 * sin], axis=-1).astype(x.dtype)


def mla_attention(c_q, c_kv, k_rope_raw, positions, q_norm_g, w_uq, kv_norm_g, w_ukv):
    b, s, _ = c_q.shape
    q = (rmsnorm(c_q, q_norm_g) @ w_uq).reshape(b, s, MLA_HEADS, MLA_NOPE + MLA_ROPE)
    q_nope, q_rope = q[..., :MLA_NOPE], q[..., MLA_NOPE:]
    kv = (rmsnorm(c_kv, kv_norm_g) @ w_ukv).reshape(b, s, MLA_HEADS, MLA_NOPE + MLA_V)
    k_nope, v = kv[..., :MLA_NOPE], kv[..., MLA_NOPE:]
    inv_freq = ROPE_THETA ** (-jnp.arange(0, MLA_ROPE, 2, dtype=jnp.float32) / MLA_ROPE)
    ang = positions[..., None].astype(jnp.float32) * inv_freq
    cos, sin = jnp.cos(ang), jnp.sin(ang)
    q_rope = apply_rope(q_rope, cos[:, :, None, :], sin[:, :, None, :])
    k_rope = apply_rope(k_rope_raw, cos, sin)
    scale = (MLA_NOPE + MLA_ROPE) ** -0.5
    outs = []
    for start in range(0, s, ATTN_BLOCK):
        end = start + ATTN_BLOCK
        sc = (jnp.einsum('bqhd,bkhd->bhqk', q_nope[:, start:end], k_nope[:, :end])
              + jnp.einsum('bqhr,bkr->bhqk', q_rope[:, start:end], k_rope[:, :end]))
        sc = sc.astype(jnp.float32) * scale
        causal = jnp.arange(end)[None, :] <= jnp.arange(start, end)[:, None]
        p = jax.nn.softmax(jnp.where(causal, sc, -jnp.inf), axis=-1).astype(v.dtype)
        outs.append(jnp.einsum('bhqk,bkhd->bqhd', p, v[:, :end]))
    o = jnp.concatenate(outs, axis=1)
    return o.reshape(b, s, MLA_HEADS * MLA_V)


def even_mixer(h, positions, w_in, conv_w, q_norm_g, w_uq, kv_norm_g, w_ukv, w_out):
    gate_b, gate_c, u, c_q, c_kv, k_rope = _split(h @ w_in, EVEN_SPLITS)
    sc_out = gate_b * causal_dwconv(gate_c * u, conv_w)
    mla_out = mla_attention(c_q, c_kv, k_rope, positions, q_norm_g, w_uq, kv_norm_g, w_ukv)
    return jnp.concatenate([sc_out, mla_out.astype(h.dtype)], axis=-1) @ w_out


def gla_chunked(q, k, v, log_a):
    b, s = q.shape[:2]
    n = s // GLA_CHUNK

    def chunk(t):
        return t.reshape(b, n, GLA_CHUNK, GLA_HEADS, t.shape[-1]).transpose(0, 3, 1, 2, 4)

    qc = chunk(q) * (GLA_DK ** -0.5)
    kc = chunk(k)
    vc = chunk(v)
    cum = jnp.cumsum(chunk(log_a).astype(jnp.float32), axis=3)
    last = cum[:, :, :, -1:, :]
    q_in = qc * jnp.exp(cum)
    k_in = kc * jnp.exp(-cum)
    k_out = kc * jnp.exp(last - cum)
    mask = jnp.tril(jnp.ones((GLA_CHUNK, GLA_CHUNK), dtype=bool))
    att = jnp.where(mask, jnp.einsum('bhnid,bhnjd->bhnij', q_in, k_in), 0.0)
    o_intra = jnp.einsum('bhnij,bhnjv->bhniv', att, vc)
    kv = jnp.einsum('bhnjd,bhnjv->bhndv', k_out, vc).astype(jnp.float32)
    decay = jnp.exp(last[:, :, :, 0, :])

    def step(state, inp):
        d, kv_n = inp
        return d[..., None] * state + kv_n, state

    init = jnp.zeros((b, GLA_HEADS, GLA_DK, GLA_DV), jnp.float32)
    _, states = lax.scan(step, init, (jnp.moveaxis(decay, 2, 0), jnp.moveaxis(kv, 2, 0)))
    states = jnp.moveaxis(states, 0, 2)
    o_inter = jnp.einsum('bhnid,bhndv->bhniv', q_in, states)
    o = o_intra + o_inter
    return o.transpose(0, 2, 3, 1, 4).reshape(b, s, GLA_HEADS, GLA_DV)


def rglru(xc, w_a, b_a, w_i, b_i, lam):
    b, s, c = xc.shape
    xb = xc.reshape(b, s, LRU_BLOCKS, c // LRU_BLOCKS)
    r = jax.nn.sigmoid(jnp.einsum('bsnc,ncd->bsnd', xb, w_a).reshape(b, s, c) + b_a)
    i = jax.nn.sigmoid(jnp.einsum('bsnc,ncd->bsnd', xb, w_i).reshape(b, s, c) + b_i)
    log_a = (-LRU_C * r.astype(jnp.float32)) * jax.nn.softplus(-lam.astype(jnp.float32))
    a = jnp.exp(log_a)
    inp = jnp.sqrt(-jnp.expm1(2.0 * log_a)) * (i * xc).astype(jnp.float32)

    def combine(left, right):
        a1, b1 = left
        a2, b2 = right
        return a1 * a2, a2 * b1 + b2

    _, hseq = lax.associative_scan(combine, (a, inp), axis=1)
    return hseq.astype(xc.dtype)


def odd_mixer(h, w_in, gate_up, gate_bias, gla_norm_g, conv_w, conv_b, w_a, b_a, w_i, b_i, lam, w_out):
    b, s, _ = h.shape
    q, k, v, g_lr, o_gate, x_lru, y_lru = _split(h @ w_in, ODD_SPLITS)
    log_a = jax.nn.log_sigmoid((g_lr @ gate_up + gate_bias).astype(jnp.float32)) / GLA_TAU
    o = gla_chunked(q.reshape(b, s, GLA_HEADS, GLA_DK), k.reshape(b, s, GLA_HEADS, GLA_DK),
                    v.reshape(b, s, GLA_HEADS, GLA_DV), log_a.reshape(b, s, GLA_HEADS, GLA_DK))
    o = rmsnorm(o, gla_norm_g).reshape(b, s, GLA_HEADS * GLA_DV)
    gla_out = (o * jax.nn.silu(o_gate)).astype(h.dtype)
    xc = causal_dwconv(x_lru, conv_w) + conv_b
    lru_out = jax.nn.gelu(y_lru) * rglru(xc, w_a, b_a, w_i, b_i, lam)
    return jnp.concatenate([gla_out, lru_out.astype(h.dtype)], axis=-1) @ w_out


def setup_inputs(seed: int = 0) -> dict:
    key = jax.random.key(seed)
    ks = list(jax.random.split(key, 40))
    f32 = jnp.float32

    def nrm(shape, fan_in):
        return jax.random.normal(ks.pop(), shape, f32) * (fan_in ** -0.5)

    def gain(shape):
        return 1.0 + 0.02 * jax.random.normal(ks.pop(), shape, f32)

    def bias(shape):
        return 0.01 * jax.random.normal(ks.pop(), shape, f32)

    x = jax.random.normal(ks.pop(), (BATCH, SEQ, D_MODEL), f32)
    offset = jax.random.randint(ks.pop(), (BATCH, 1), 0, 1024, dtype=jnp.int32)
    positions = offset + jnp.arange(SEQ, dtype=jnp.int32)[None, :]
    u = jax.random.uniform(ks.pop(), (N_ODD, LRU_WIDTH), f32, minval=0.9, maxval=0.999)
    sg = u ** (1.0 / LRU_C)
    lru_lambda = jnp.log(sg) - jnp.log1p(-sg)
    blk = LRU_WIDTH // LRU_BLOCKS
    return {
        'x': x,
        'positions': positions,
        'mixer_norm_g': gain((DEPTH, D_MODEL)),
        'mlp_norm_g': gain((DEPTH, D_MODEL)),
        'mlp_w1': nrm((DEPTH, D_MODEL, D_FF), D_MODEL),
        'mlp_w2': nrm((DEPTH, D_FF, D_MODEL), D_FF),
        'final_norm_g': gain((D_MODEL,)),
        'ev_w_in': nrm((N_EVEN, D_MODEL, EVEN_IN), D_MODEL),
        'ev_conv_w': nrm((N_EVEN, SC_KERNEL, SC_WIDTH), SC_KERNEL),
        'mla_q_norm_g': gain((N_EVEN, MLA_Q_RANK)),
        'mla_w_uq': nrm((N_EVEN, MLA_Q_RANK, MLA_HEADS * (MLA_NOPE + MLA_ROPE)), MLA_Q_RANK),
        'mla_kv_norm_g': gain((N_EVEN, MLA_KV_RANK)),
        'mla_w_ukv': nrm((N_EVEN, MLA_KV_RANK, MLA_HEADS * (MLA_NOPE + MLA_V)), MLA_KV_RANK),
        'ev_w_out': nrm((N_EVEN, EVEN_MIX, D_MODEL), EVEN_MIX),
        'od_w_in': nrm((N_ODD, D_MODEL, ODD_IN), D_MODEL),
        'gla_w_gate_up': nrm((N_ODD, GLA_GATE_RANK, GLA_HEADS * GLA_DK), GLA_GATE_RANK),
        'gla_b_gate': bias((N_ODD, GLA_HEADS * GLA_DK)),
        'gla_norm_g': gain((N_ODD, GLA_DV)),
        'lru_conv_w': nrm((N_ODD, LRU_KERNEL, LRU_WIDTH), LRU_KERNEL),
        'lru_conv_b': bias((N_ODD, LRU_WIDTH)),
        'lru_w_a': nrm((N_ODD, LRU_BLOCKS, blk, blk), blk),
        'lru_b_a': bias((N_ODD, LRU_WIDTH)),
        'lru_w_i': nrm((N_ODD, LRU_BLOCKS, blk, blk), blk),
        'lru_b_i': bias((N_ODD, LRU_WIDTH)),
        'lru_lambda': lru_lambda,
        'od_w_out': nrm((N_ODD, ODD_MIX, D_MODEL), ODD_MIX),
    }


def reference(x, positions, mixer_norm_g, mlp_norm_g, mlp_w1, mlp_w2, final_norm_g,
              ev_w_in, ev_conv_w, mla_q_norm_g, mla_w_uq, mla_kv_norm_g, mla_w_ukv, ev_w_out,
              od_w_in, gla_w_gate_up, gla_b_gate, gla_norm_g, lru_conv_w, lru_conv_b,
              lru_w_a, lru_b_a, lru_w_i, lru_b_i, lru_lambda, od_w_out):
    h = x
    for layer in range(DEPTH):
        j = layer // 2
        hn = rmsnorm(h, mixer_norm_g[layer])
        if layer % 2 == 0:
            mix = even_mixer(hn, positions, ev_w_in[j], ev_conv_w[j], mla_q_norm_g[j], mla_w_uq[j],
                             mla_kv_norm_g[j], mla_w_ukv[j], ev_w_out[j])
        else:
            mix = odd_mixer(hn, od_w_in[j], gla_w_gate_up[j], gla_b_gate[j], gla_norm_g[j],
                            lru_conv_w[j], lru_conv_b[j], lru_w_a[j], lru_b_a[j], lru_w_i[j],
                            lru_b_i[j], lru_lambda[j], od_w_out[j])
        h = h + mix.astype(h.dtype)
        hn = rmsnorm(h, mlp_norm_g[layer])
        h = h + (jnp.square(jax.nn.relu(hn @ mlp_w1[layer])) @ mlp_w2[layer]).astype(h.dtype)
    return rmsnorm(h, final_norm_g)
```

```cpp
#include <hip/hip_runtime.h>
#include <hip/hip_cooperative_groups.h>
#include <stdint.h>
#include <stdio.h>
namespace cg = cooperative_groups;

#ifndef MK_MULTI
#define MK_MULTI 0
#endif

typedef unsigned short bf16_t;
typedef short bf16x8 __attribute__((ext_vector_type(8)));
typedef short s16x4 __attribute__((ext_vector_type(4)));
typedef float f32x4 __attribute__((ext_vector_type(4)));
typedef float f32x2 __attribute__((ext_vector_type(2)));
typedef float f32x16 __attribute__((ext_vector_type(16)));
typedef unsigned u32x4 __attribute__((ext_vector_type(4)));
typedef unsigned u32x2 __attribute__((ext_vector_type(2)));
typedef __bf16 bf16x2_t __attribute__((ext_vector_type(2)));

#define DI __device__ __forceinline__
#ifndef PH_MASK
#define PH_MASK 0xffff
#endif
#define PHM(k) ((PH_MASK >> (k)) & 1)
#ifndef PROBE_STEP
#define PROBE_STEP -1
#endif
#ifndef PROBE_PH
#define PROBE_PH -1
#endif
__device__ __forceinline__ int tidx() { int t = threadIdx.x; asm volatile("" : "+v"(t)); return t; }

constexpr int T = 32768, S = 4096, NB = 8;
constexpr size_t MB = 1u << 20;
constexpr size_t OFF_W1T = 1 * MB, OFF_W2T = 33 * MB, OFF_EWIN = 65 * MB, OFF_WUQ = 74 * MB, OFF_WUKV = 76 * MB, OFF_EWOUT = 77 * MB,
                 OFF_OWIN = 81 * MB, OFF_OWOUT = 92 * MB, OFF_HB = 96 * MB, OFF_SSQH = 160 * MB, OFF_SSQQ = 162 * MB, OFF_SSQKV = 163 * MB,
                 OFF_R = 164 * MB, WS_NEED = 502 * MB, OFF_LRUW = 65536;
constexpr size_t R_PROJ = 0, R_Q = 144 * MB, R_KF = 192 * MB, R_V = 240 * MB, R_MIX = 272 * MB;
constexpr size_t R_LOGA = 160 * MB, R_STATES = 192 * MB, R_DECAY = 256 * MB, R_LRUA = 257 * MB, R_LRUB = 258 * MB, R_LRUH = 259 * MB;
constexpr int EV_LD = 2304, OD_LD = 2560, HID_LD = 4096 + 128;

struct Params {
  const float* x; const int* pos;
  const float *mixer_g, *mlp_g, *w1, *w2, *final_g;
  const float *ev_w_in, *ev_conv_w, *q_norm_g, *w_uq, *kv_norm_g, *w_ukv, *ev_w_out;
  const float *od_w_in, *gate_up, *gate_b, *gla_norm_g, *lru_conv_w, *lru_conv_b, *lru_w_a, *lru_b_a, *lru_w_i, *lru_b_i, *lru_lam, *od_w_out;
  float* out; char* ws;
};

__shared__ __attribute__((aligned(1024))) char g_shm[132 * 1024];

DI unsigned pk2(float a, float b) { f32x2 v = {a, b}; bf16x2_t r = __builtin_convertvector(v, bf16x2_t); return __builtin_bit_cast(unsigned, r); }
DI bf16_t f2bf(float a) { return (bf16_t)(pk2(a, 0.f) & 0xffffu); }
DI float bf2f(bf16_t v) { return __uint_as_float(((unsigned)v) << 16); }
DI float bflo(unsigned u) { return __uint_as_float(u << 16); }
DI float bfhi(unsigned u) { return __uint_as_float(u & 0xffff0000u); }
DI int crow(int reg, int h) { return (reg & 3) + 8 * (reg >> 2) + 4 * h; }
#define MFMA32(a, b, c) __builtin_amdgcn_mfma_f32_32x32x16_bf16((a), (b), (c), 0, 0, 0)
#define MFMA16(a, b, c) __builtin_amdgcn_mfma_f32_16x16x32_bf16((a), (b), (c), 0, 0, 0)
#define WAIT_V0() asm volatile("s_waitcnt vmcnt(0)" ::: "memory")
DI bf16x8 pack8(const f32x16& x, int s) {
  u32x4 p;
  p.x = pk2(x[8 * s + 0], x[8 * s + 1]); p.y = pk2(x[8 * s + 2], x[8 * s + 3]);
  p.z = pk2(x[8 * s + 4], x[8 * s + 5]); p.w = pk2(x[8 * s + 6], x[8 * s + 7]);
  return __builtin_bit_cast(bf16x8, p);
}
DI float fexp(float x) { return __builtin_amdgcn_exp2f(x * 1.4426950408889634f); }
DI float frcp(float x) { return __builtin_amdgcn_rcpf(x); }
DI float sigmoidf_(float x) { return frcp(1.f + fexp(-x)); }


#define XB_TMO      128
#define XB_XCNT(j)  (256  + 64 * (j))
#define XB_XSUB(j)  (1280 + 64 * (j))
#define XB_XGEN(j)  (2304 + 64 * (j))
#define XB_TOP      3328
#define XB_TOPGEN   3392
#define XCD_BAR_WORDS 3456
#define XB_SPIN_CAP (1u << 22)
#define LAS __attribute__((address_space(3)))
DI unsigned xb_ld(unsigned* p)              { return __hip_atomic_load(p, __ATOMIC_RELAXED, __HIP_MEMORY_SCOPE_AGENT); }
DI unsigned xb_add(unsigned* p, unsigned v) { return __hip_atomic_fetch_add(p, v, __ATOMIC_RELAXED, __HIP_MEMORY_SCOPE_AGENT); }
DI unsigned xb_xcc_id() { return (unsigned)__builtin_amdgcn_s_getreg((3 << 11) | 20) & 0xFu; }
#define XB_SPIN(cond, bar) do { unsigned _sp = 0; while (cond) { __builtin_amdgcn_s_sleep(1); \
    if ((++_sp & 255u) == 0u) { if (xb_ld(&(bar)[XB_TMO])) break; if (_sp > XB_SPIN_CAP) { atomicAdd(&(bar)[XB_TMO], 1u); break; } } } } while (0)
struct XcdBarrier { unsigned* bar; unsigned x; volatile LAS unsigned* st; };
DI XcdBarrier xcd_barrier_post(unsigned* bar, volatile LAS unsigned* st) {
  XcdBarrier b; b.bar = bar; b.x = xb_xcc_id(); b.st = st;
  if (threadIdx.x == 0) (void)xb_add(&bar[XB_XCNT(b.x)], 1u);
  return b;
}
DI void xcd_barrier_complete(unsigned* bar, unsigned x, unsigned& nloc, unsigned& nx) {
  const unsigned G = gridDim.x * gridDim.y * gridDim.z;
  unsigned sum, cnt, mine, sp = 0u;
  for (;;) {
    sum = 0u; cnt = 0u; mine = 0u;
#pragma unroll
    for (unsigned j = 0; j < 16; ++j) { const unsigned c = xb_ld(&bar[XB_XCNT(j)]); sum += c; cnt += (c > 0u) ? 1u : 0u; mine = (j == x) ? c : mine; }
    if (sum == G) break;
    __builtin_amdgcn_s_sleep(1);
    if ((++sp & 255u) == 0u) { if (xb_ld(&bar[XB_TMO])) break; if (sp > XB_SPIN_CAP) { atomicAdd(&bar[XB_TMO], 1u); break; } }
  }
  nloc = mine > 0u ? mine : 1u; nx = cnt > 0u ? cnt : 1u;
}
DI void xcd_barrier(const XcdBarrier& b) {
  asm volatile("s_waitcnt vmcnt(0)" ::: "memory");
  __syncthreads();
  if (threadIdx.x == 0) {
    unsigned* bar = b.bar;
    __builtin_amdgcn_s_waitcnt(0);
    unsigned nloc = b.st[0], nx = b.st[1];
    if (nloc == 0u) { xcd_barrier_complete(bar, b.x, nloc, nx); b.st[0] = nloc; b.st[1] = nx; }
    const unsigned old = xb_add(&bar[XB_XSUB(b.x)], 1u);
    const unsigned gen = old / nloc;
    if (old + 1u == (gen + 1u) * nloc) {
      __builtin_amdgcn_fence(__ATOMIC_RELEASE, "agent");
      asm volatile("s_waitcnt vmcnt(0)" ::: "memory");
      const unsigned og = xb_add(&bar[XB_TOP], 1u);
      const unsigned tg = og / nx;
      if (og + 1u == (tg + 1u) * nx) xb_add(&bar[XB_TOPGEN], 1u);
      else XB_SPIN(xb_ld(&bar[XB_TOPGEN]) == tg, bar);
      __builtin_amdgcn_fence(__ATOMIC_ACQUIRE, "agent");
      xb_add(&bar[XB_XGEN(b.x)], 1u);
      asm volatile("s_waitcnt vmcnt(0)" ::: "memory");
    } else {
      XB_SPIN(xb_ld(&bar[XB_XGEN(b.x)]) == gen, bar);
      __builtin_amdgcn_fence(__ATOMIC_ACQUIRE, "agent");
      asm volatile("s_waitcnt vmcnt(0)" ::: "memory");
    }
  }
  __syncthreads();
}
constexpr int XB_LDS_OFF = 133120;

DI void zero_f32(float* p, int n) {
  for (int i = blockIdx.x * blockDim.x + tidx(); i < n; i += gridDim.x * blockDim.x) p[i] = 0.f;
}
DI int map_col(int mode, int n) {
  if (mode == 0) return n;
  if (mode == 1) { if (n < 1536) return n; if (n < 1792) return 1920 + (n - 1536); if (n < 2176) return 1536 + (n - 1792); if (n < 2208) { const int pp = n - 2176; return 2176 + 16 * ((pp >> 2) & 1) + 4 * (pp >> 3) + (pp & 3); } return -1; }
  if (mode == 2) { if (n < 512) return (n >> 6) * 128 + (n & 63); int m = n - 512; return (m >> 6) * 128 + 64 + (m & 63); }
  if (mode == 4) { const int h = n / 96, w = n % 96; if (w < 64) return n; const int pp = w - 64; return h * 96 + 64 + 16 * ((pp >> 2) & 1) + 4 * (pp >> 3) + (pp & 3); }
    if (n < 1024) return n; if (n < 2560) return n + 16; return -2 - (n - 2560);
}
struct PrepJob { const float* W; int K, N; bf16_t* dst; int Npad; const float* gain; int mode; const float* aux; };
DI PrepJob prep_get(const Params& p, int id) {
  char* ws = p.ws; PrepJob jb{};
  if (id < 4) { const int l = id; jb.W = p.w1 + (long)l * 1024 * 4096; jb.K = 1024; jb.N = 4096; jb.dst = (bf16_t*)(ws + OFF_W1T) + (long)l * 4096 * 1024; jb.Npad = 4096; jb.gain = p.mlp_g + l * 1024; jb.mode = 0; }
  else if (id < 8) { const int l = id - 4; jb.W = p.w2 + (long)l * 4096 * 1024; jb.K = 4096; jb.N = 1024; jb.dst = (bf16_t*)(ws + OFF_W2T) + (long)l * 4096 * 1024; jb.Npad = 1024; jb.gain = nullptr; jb.mode = 0; }
  else if (id >= 20) {
    const int q = id - 20, gate = q >> 4, jj = (q >> 3) & 1, blk = q & 7;
    jb.W = (gate ? p.lru_w_i : p.lru_w_a) + (long)(jj * 8 + blk) * 4096; jb.K = 64; jb.N = 64; jb.dst = (bf16_t*)(ws + OFF_LRUW) + (long)q * 4096; jb.Npad = 64; jb.gain = nullptr; jb.mode = 0;
  } else {
    const int j = (id - 8) / 6, t = (id - 8) % 6;
    if (t == 0) { jb.W = p.ev_w_in + (long)j * 1024 * 2208; jb.K = 1024; jb.N = 2208; jb.dst = (bf16_t*)(ws + OFF_EWIN) + (long)j * 2304 * 1024; jb.Npad = 2304; jb.gain = p.mixer_g + (2 * j) * 1024; jb.mode = 1; }
    else if (t == 1) { jb.W = p.w_uq + (long)j * 384 * 768; jb.K = 384; jb.N = 768; jb.dst = (bf16_t*)(ws + OFF_WUQ) + (long)j * 768 * 384; jb.Npad = 768; jb.gain = p.q_norm_g + j * 384; jb.mode = 4; }
    else if (t == 2) { jb.W = p.w_ukv + (long)j * 256 * 1024; jb.K = 256; jb.N = 1024; jb.dst = (bf16_t*)(ws + OFF_WUKV) + (long)j * 1024 * 256; jb.Npad = 1024; jb.gain = p.kv_norm_g + j * 256; jb.mode = 2; }
    else if (t == 3) { jb.W = p.ev_w_out + (long)j * 1024 * 1024; jb.K = 1024; jb.N = 1024; jb.dst = (bf16_t*)(ws + OFF_EWOUT) + (long)j * 1024 * 1024; jb.Npad = 1024; jb.gain = nullptr; jb.mode = 0; }
    else if (t == 4) { jb.W = p.od_w_in + (long)j * 1024 * 2576; jb.K = 1024; jb.N = 2576; jb.dst = (bf16_t*)(ws + OFF_OWIN) + (long)j * 2816 * 1024; jb.Npad = 2816; jb.gain = p.mixer_g + (2 * j + 1) * 1024; jb.mode = 3; jb.aux = p.gate_up + j * 16 * 256; }
    else { jb.W = p.od_w_out + (long)j * 1024 * 1024; jb.K = 1024; jb.N = 1024; jb.dst = (bf16_t*)(ws + OFF_OWOUT) + (long)j * 1024 * 1024; jb.Npad = 1024; jb.gain = nullptr; jb.mode = 0; }
  }
  return jb;
}
DI void prep_load(const PrepJob& jb, int tile, int ntn, bool fast, float (&rg)[16]) {
  const int tid = tidx();
  const float* __restrict__ W = jb.W; const int N = jb.N;
  const int k0 = (tile / ntn) * 64, n0 = (tile % ntn) * 128;
  if (fast) {
#pragma unroll
    for (int q = 0; q < 4; ++q) {
      const int i = tid + 512 * q, row = i >> 5, c4 = i & 31;
      f32x4 v = *(const f32x4*)(W + (long)(k0 + row) * N + n0 + c4 * 4);
      if (jb.gain) v = v * jb.gain[k0 + row];
      rg[4 * q] = v[0]; rg[4 * q + 1] = v[1]; rg[4 * q + 2] = v[2]; rg[4 * q + 3] = v[3];
    }
  } else {
    const int nl = tid & 127, src = map_col(jb.mode, n0 + nl);
#pragma unroll
    for (int q = 0; q < 16; ++q) {
      const int row = (tid >> 7) + 4 * q, k = k0 + row;
      float w;
      if (src >= 0) w = W[(long)k * N + src];
      else if (src == -1) w = 0.f;
      else { const int cc = -2 - src; float sm = 0.f; for (int r = 0; r < 16; ++r) sm += W[(long)k * N + 1024 + r] * jb.aux[r * 256 + cc]; w = sm; }
      if (jb.gain) w *= jb.gain[k];
      rg[q] = w;
    }
  }
}
DI int prep_ntiles(const PrepJob& jb) { return (jb.K / 64) * (jb.Npad / 128); }
DI PrepJob prep_find(const Params& p, int gt, int& lt) {
  PrepJob jb = prep_get(p, 0);
  for (int id = 0; id < 20; ++id) {
    jb = prep_get(p, id);
    const int n = prep_ntiles(jb);
    if (gt < n) break;
    gt -= n;
  }
  lt = gt; return jb;
}
DI void phase_prep(const Params& p) {
  char* ws = p.ws;
  {
    float* tl = (float*)g_shm;
    const int tid = tidx();
    int total = 0;
    for (int id = 0; id < 20; ++id) total += prep_ntiles(prep_get(p, id));
    int gt = blockIdx.x, lt = 0;
    float rg[16];
    PrepJob jb = prep_get(p, 0);
    if (gt < total) { jb = prep_find(p, gt, lt); prep_load(jb, lt, jb.Npad / 128, jb.mode == 0 && jb.N == jb.Npad, rg); }
    while (gt < total) {
      const int K = jb.K, ntn = jb.Npad / 128;
      const bool fast = (jb.mode == 0 && jb.N == jb.Npad);
      const int k0 = (lt / ntn) * 64, n0 = (lt % ntn) * 128;
      bf16_t* dst = jb.dst;
      __syncthreads();
      if (fast) {
#pragma unroll
        for (int q = 0; q < 4; ++q) {
          const int i = tid + 512 * q, row = i >> 5, c4 = i & 31;
          float* d = tl + row * 129 + c4 * 4;
          d[0] = rg[4 * q]; d[1] = rg[4 * q + 1]; d[2] = rg[4 * q + 2]; d[3] = rg[4 * q + 3];
        }
      } else {
#pragma unroll
        for (int q = 0; q < 16; ++q) tl[((tid >> 7) + 4 * q) * 129 + (tid & 127)] = rg[q];
      }
      __syncthreads();
      gt += gridDim.x;
      if (gt < total) { jb = prep_find(p, gt, lt); prep_load(jb, lt, jb.Npad / 128, jb.mode == 0 && jb.N == jb.Npad, rg); }
#pragma unroll
      for (int q = 0; q < 2; ++q) {
        const int o = tid + 512 * q, n = o >> 3, kc = o & 7;
        const float* sp = tl + (kc * 8) * 129 + n;
        u32x4 w;
        w.x = pk2(sp[0], sp[129]); w.y = pk2(sp[2 * 129], sp[3 * 129]); w.z = pk2(sp[4 * 129], sp[5 * 129]); w.w = pk2(sp[6 * 129], sp[7 * 129]);
        *(u32x4*)(dst + (long)(n0 + n) * K + k0 + kc * 8) = w;
      }
    }
  }
  {
    for (int c = blockIdx.x * blockDim.x + tidx(); c < 32 * 512; c += gridDim.x * blockDim.x) {
      const int q = c >> 9, w9 = c & 511, gate = q >> 4, jj = (q >> 3) & 1, blk = q & 7;
      const float* W = (gate ? p.lru_w_i : p.lru_w_a) + (long)(jj * 8 + blk) * 4096;
      bf16_t* dst = (bf16_t*)(ws + OFF_LRUW) + (long)q * 4096;
      const int n = w9 & 63, k0 = (w9 >> 6) * 8;
      float v[8];
#pragma unroll
      for (int e = 0; e < 8; ++e) v[e] = W[(k0 + e) * 64 + n];
      u32x4 o; o.x = pk2(v[0], v[1]); o.y = pk2(v[2], v[3]); o.z = pk2(v[4], v[5]); o.w = pk2(v[6], v[7]);
      *(u32x4*)(dst + n * 64 + k0) = o;
    }
  }
  bf16_t* hb = (bf16_t*)(ws + OFF_HB);
  float* ssq = (float*)(ws + OFF_SSQH);
  const int lane = tidx() & 63, gw = (blockIdx.x * blockDim.x + tidx()) >> 6, nw = (gridDim.x * blockDim.x) >> 6;
  for (int row0 = gw; row0 < T; row0 += 4 * nw) {
    f32x4 v[4][4];
#pragma unroll
    for (int k = 0; k < 4; ++k) {
      const int row = row0 + k * nw;
      if (row < T) {
#pragma unroll
        for (int i = 0; i < 4; ++i) v[k][i] = *(const f32x4*)(p.x + (long)row * 1024 + i * 256 + lane * 4);
      }
    }
#pragma unroll
    for (int k = 0; k < 4; ++k) {
      const int row = row0 + k * nw;
      if (row < T) {
        float ss = 0.f;
#pragma unroll
        for (int i = 0; i < 4; ++i) {
          ss += v[k][i][0] * v[k][i][0] + v[k][i][1] * v[k][i][1] + v[k][i][2] * v[k][i][2] + v[k][i][3] * v[k][i][3];
          u32x2 o; o.x = pk2(v[k][i][0], v[k][i][1]); o.y = pk2(v[k][i][2], v[k][i][3]);
          *(u32x2*)(hb + (long)row * 1024 + i * 256 + lane * 4) = o;
        }
#pragma unroll
        for (int d = 1; d < 64; d <<= 1) ss += __shfl_xor(ss, d);
        if (lane < 16) ssq[(long)row * 16 + lane] = (lane == 0) ? ss : 0.f;
      }
    }
  }
}

namespace pg8 {
constexpr int BM = 256, BK = 64, HALF = 128, HTB = HALF * BK * 2, STAGE_BYTES = 8 * HTB, NXCD = 8, WGM = 8;
DI int lds_byte(int r, int c) { const int st = (r >> 4) * 2 + (c >> 5), rr = r & 15, cc = c & 31, ob = rr * 64 + cc * 2; return st * 1024 + (ob ^ (((ob >> 9) & 1) << 5)); }
DI void stage_rc(int b, int& R, int& C) { const int st = b / 1024, sb = b % 1024, swz = sb ^ (((sb >> 9) & 1) << 5); R = (st >> 1) * 16 + swz / 64; C = (st & 1) * 32 + (swz % 64) / 2; }
DI int perm32(int rho) { const int n = rho >> 4, i = rho & 15; return 8 * (i >> 2) + 4 * n + (i & 3); }
struct Unit { int pm, pn; };
struct Gemm { const bf16_t* A; const bf16_t* Bt; int lda, K, nN; };
struct StaticOrder {
  int nM, nN, nwg, G, c;
  DI void init(int M, int nN_, int G_, int c_) { nM = M / BM; nN = nN_; nwg = nM * nN; G = G_; c = c_; }
  DI bool next(int i, Unit& u) const {
    const long L = (long)i * G + c; if (L >= nwg) return false;
    int wgid = (int)L; { const int q = nwg / NXCD, r = nwg % NXCD, xcd = wgid % NXCD, off = wgid / NXCD; wgid = (xcd < r ? xcd * (q + 1) : r * (q + 1) + (xcd - r) * q) + off; }
    const int nig = WGM * nN, gid = wgid / nig, fm = gid * WGM, gsz = (nM - fm) < WGM ? (nM - fm) : WGM;
    u.pm = fm + ((wgid % nig) % gsz); u.pn = (wgid % nig) / gsz; return true;
  }
};

template <class Epi, bool ALIGN_EPI = true>
DI void gemm_phase(const Gemm g, const StaticOrder& S, const Epi& E) {
  LAS unsigned char* lds = (LAS unsigned char*)g_shm;
  const int tid = tidx(), wid = __builtin_amdgcn_readfirstlane(tid >> 6), lane = tid & 63, wr = wid >> 2, wc = wid & 3, fr = lane & 15, fq = lane >> 4;
  const int K = g.K, nt = K / BK, lda = g.lda;
  unsigned voffA[2], voffB[2];
#pragma unroll
  for (int i = 0; i < 2; ++i) { int R, C; stage_rc(tid * 16 + i * 8192, R, C); const int Rb = (R & ~31) + perm32(R & 31);
    voffA[i] = (unsigned)(R * lda + C) * 2u; voffB[i] = (unsigned)(Rb * K + C) * 2u; }
  const size_t kstep = (size_t)(BK * 2);
  const size_t hstepA = (size_t)HALF * lda * 2, hstepB = (size_t)HALF * K * 2;
  const size_t tstepA = 2 * hstepA, tstepB = 2 * hstepB;
  const unsigned ldsw = (unsigned)wid * 1024u;
  const int aoff = lds_byte(wr * 64 + fr, fq * 8), boff = lds_byte(wc * 32 + fr, fq * 8);
#define PG8_SA(b, h) (((b) * 2 + (h)) * HTB)
#define PG8_SB(b, h) ((4 + (b) * 2 + (h)) * HTB)
#define PG8_STAGE(bufoff, gbase, voff) do { _Pragma("unroll") for (int _i = 0; _i < 2; ++_i) \
    __builtin_amdgcn_global_load_lds((const unsigned*)((const char*)(gbase) + (voff)[_i]), (LAS unsigned*)(lds + (bufoff) + ldsw + _i * 8192), 16, 0, 0); } while (0)
#define PG8_LDA(dst, b, h) do { _Pragma("unroll") for (int m = 0; m < 4; ++m) _Pragma("unroll") for (int k = 0; k < 2; ++k) dst[m][k] = *(const LAS bf16x8*)(lds + PG8_SA(b, h) + aoff + m * 2048 + k * 1024); } while (0)
#define PG8_LDB(dst, b, h) do { _Pragma("unroll") for (int n = 0; n < 2; ++n) _Pragma("unroll") for (int k = 0; k < 2; ++k) dst[n][k] = *(const LAS bf16x8*)(lds + PG8_SB(b, h) + boff + n * 2048 + k * 1024); } while (0)
#define PG8_MMA(ai, bj, At, Bt) do { __builtin_amdgcn_s_setprio(1); _Pragma("unroll") for (int m = 0; m < 4; ++m) _Pragma("unroll") for (int n = 0; n < 2; ++n) _Pragma("unroll") for (int k = 0; k < 2; ++k) \
    acc[ai][bj][m][n] = __builtin_amdgcn_mfma_f32_16x16x32_bf16(Bt[n][k], At[m][k], acc[ai][bj][m][n], 0, 0, 0); __builtin_amdgcn_s_setprio(0); } while (0)
#define PG8_WAIT_V(n) asm volatile("s_waitcnt vmcnt(" #n ")" ::: "memory")
#define PG8_WAIT_L(n) asm volatile("s_waitcnt lgkmcnt(" #n ")" ::: "memory")
#define PG8_BAR __builtin_amdgcn_s_barrier()
#define PG8_SCHED __builtin_amdgcn_sched_barrier(0)
  __syncthreads();
  Unit cur, nxt; int ui = 0;
  if (!S.next(0, cur)) return;
  f32x4 acc[2][2][4][2];
#pragma unroll
  for (int a = 0; a < 2; ++a)
#pragma unroll
    for (int b = 0; b < 2; ++b)
#pragma unroll
      for (int m = 0; m < 4; ++m)
#pragma unroll
        for (int n = 0; n < 2; ++n) acc[a][b][m][n] = (f32x4){0.f, 0.f, 0.f, 0.f};
  bf16x8 At[4][2], B0[2][2], B1[2][2];
  const char* cA = (const char*)g.A + (size_t)cur.pm * tstepA; const char* cB = (const char*)g.Bt + (size_t)cur.pn * tstepB;
  PG8_STAGE(PG8_SB(0, 0), cB, voffB); PG8_STAGE(PG8_SB(0, 1), cB + hstepB, voffB); PG8_STAGE(PG8_SA(0, 0), cA, voffA); PG8_STAGE(PG8_SA(0, 1), cA + hstepA, voffA);
  if (wr == 1) PG8_BAR;
  PG8_WAIT_V(2); PG8_BAR;
  PG8_STAGE(PG8_SB(1, 0), cB + kstep, voffB); PG8_STAGE(PG8_SA(1, 0), cA + kstep, voffA); PG8_STAGE(PG8_SB(1, 1), cB + hstepB + kstep, voffB);
  PG8_WAIT_V(6); PG8_BAR;
  for (;;) {
    const bool has_next = S.next(ui + 1, nxt);
    const char* nA = has_next ? (const char*)g.A + (size_t)nxt.pm * tstepA : cA; const char* nB = has_next ? (const char*)g.Bt + (size_t)nxt.pn * tstepB : cB;
#pragma nounroll
    for (int t = 0; t < nt; t += 2) {
      const bool last = (t == nt - 2);
      const char* a1 = cA + (size_t)(t + 1) * kstep;
      const char* a2 = last ? nA : cA + (size_t)(t + 2) * kstep; const char* b2 = last ? nB : cB + (size_t)(t + 2) * kstep;
      const char* a3 = a2 + kstep; const char* b3 = b2 + kstep;
      PG8_LDB(B0, 0, 0); PG8_LDB(B1, 0, 1); PG8_SCHED; PG8_LDA(At, 0, 0); PG8_STAGE(PG8_SA(1, 1), a1 + hstepA, voffA);
      PG8_WAIT_V(8); PG8_WAIT_L(0); PG8_BAR; PG8_MMA(0, 0, At, B0); PG8_MMA(0, 1, At, B1); PG8_BAR; PG8_SCHED;
      PG8_LDA(At, 0, 1); PG8_STAGE(PG8_SB(0, 0), b2, voffB); PG8_STAGE(PG8_SB(0, 1), b2 + hstepB, voffB); PG8_STAGE(PG8_SA(0, 0), a2, voffA);
      PG8_WAIT_V(8); PG8_WAIT_L(0); PG8_BAR; PG8_MMA(1, 0, At, B0); PG8_MMA(1, 1, At, B1); PG8_BAR; PG8_SCHED;
      PG8_LDB(B0, 1, 0); PG8_LDB(B1, 1, 1); PG8_SCHED; PG8_LDA(At, 1, 0); PG8_STAGE(PG8_SA(0, 1), a2 + hstepA, voffA);
      PG8_WAIT_V(8); PG8_WAIT_L(0); PG8_BAR; PG8_MMA(0, 0, At, B0); PG8_MMA(0, 1, At, B1); PG8_BAR; PG8_SCHED;
      PG8_LDA(At, 1, 1); PG8_STAGE(PG8_SB(1, 0), b3, voffB); PG8_STAGE(PG8_SB(1, 1), b3 + hstepB, voffB); PG8_STAGE(PG8_SA(1, 0), a3, voffA);
      PG8_WAIT_V(8); PG8_WAIT_L(0); PG8_BAR; PG8_MMA(1, 0, At, B0); PG8_MMA(1, 1, At, B1); PG8_BAR; PG8_SCHED;
    }
    if constexpr (ALIGN_EPI) { if (wr == 0) PG8_BAR; }
    E(acc, cur, wr, wc, fr, fq);
    if (!has_next) break;
#pragma unroll
    for (int a = 0; a < 2; ++a)
#pragma unroll
      for (int b = 0; b < 2; ++b)
#pragma unroll
        for (int m = 0; m < 4; ++m)
#pragma unroll
          for (int n = 0; n < 2; ++n) acc[a][b][m][n] = (f32x4){0.f, 0.f, 0.f, 0.f};
    cur = nxt; cA = nA; cB = nB; ++ui;
    if constexpr (ALIGN_EPI) { if (wr == 1) PG8_BAR; }
  }
  PG8_WAIT_V(0);
  if constexpr (!ALIGN_EPI) { if (wr == 0) PG8_BAR; }
  PG8_BAR;
#undef PG8_SA
#undef PG8_SB
#undef PG8_STAGE
#undef PG8_LDA
#undef PG8_LDB
#undef PG8_MMA
#undef PG8_WAIT_V
#undef PG8_WAIT_L
#undef PG8_BAR
#undef PG8_SCHED
}
}

DI void rope_ang(float pos, int i, float& sn, float& cs) {
  const float inv_freq = __builtin_amdgcn_exp2f(-(float)i * (13.287712379549449f / 16.f));
  const float ang = pos * inv_freq;
  float tr = ang * 0.15915494309189535f; tr -= rintf(tr);
  sn = __builtin_amdgcn_sinf(tr); cs = __builtin_amdgcn_cosf(tr);
}
DI u32x4 pack8v(const f32x4& a, const f32x4& b) { return (u32x4){pk2(a[0], a[1]), pk2(a[2], a[3]), pk2(b[0], b[1]), pk2(b[2], b[3])}; }
typedef f32x4 AccT[2][2][4][2];
#define EPI_ROWLOOP _Pragma("unroll") for (int ai = 0; ai < 2; ++ai) _Pragma("unroll") for (int m = 0; m < 4; ++m)
#define EPI_ROW (long)u.pm * 256 + ai * 128 + wr * 64 + m * 16 + fr

struct EpiResid {
  bf16_t* hb; float* ssq;
  DI void operator()(const AccT& acc, const pg8::Unit& u, int wr, int wc, int fr, int fq) const {
    EPI_ROWLOOP {
      const long row = EPI_ROW;
      float ss = 0.f;
#pragma unroll
      for (int bj = 0; bj < 2; ++bj) {
        bf16_t* hp = hb + row * 1024 + u.pn * 256 + bj * 128 + wc * 32 + fq * 8;
        const u32x4 r = *(const u32x4*)hp;
        f32x4 a = acc[ai][bj][m][0], b = acc[ai][bj][m][1];
        a[0] += bflo(r[0]); a[1] += bfhi(r[0]); a[2] += bflo(r[1]); a[3] += bfhi(r[1]);
        b[0] += bflo(r[2]); b[1] += bfhi(r[2]); b[2] += bflo(r[3]); b[3] += bfhi(r[3]);
        *(u32x4*)hp = pack8v(a, b);
        ss += a[0] * a[0] + a[1] * a[1] + a[2] * a[2] + a[3] * a[3] + b[0] * b[0] + b[1] * b[1] + b[2] * b[2] + b[3] * b[3];
      }
      ss += __shfl_xor(ss, 16); ss += __shfl_xor(ss, 32);
      if (fq == 0) ssq[row * 16 + u.pn * 4 + wc] = ss;
    }
  }
};
struct EpiMlp1 {
  bf16_t* hid; const float* ssq;
  DI void operator()(const AccT& acc, const pg8::Unit& u, int wr, int wc, int fr, int fq) const {
    EPI_ROWLOOP {
      const long row = EPI_ROW;
      float rs; { const f32x4 pv = *(const f32x4*)(ssq + row * 16 + fq * 4); float t = (pv[0] + pv[1]) + (pv[2] + pv[3]); t += __shfl_xor(t, 16); t += __shfl_xor(t, 32); rs = rsqrtf(t * (1.f / 1024.f) + 1e-6f); }
#pragma unroll
      for (int bj = 0; bj < 2; ++bj) {
        f32x4 a = acc[ai][bj][m][0] * rs, b = acc[ai][bj][m][1] * rs;
#pragma unroll
        for (int j = 0; j < 4; ++j) { const float x = fmaxf(a[j], 0.f), y = fmaxf(b[j], 0.f); a[j] = x * x; b[j] = y * y; }
        __builtin_nontemporal_store(pack8v(a, b), (u32x4*)(hid + row * HID_LD + u.pn * 256 + bj * 128 + wc * 32 + fq * 8));
      }
    }
  }
};
struct EpiProjEven {
  bf16_t* proj; const float* ssq; float* ssq_kv; float* ssq_q; bf16_t* kf; const int* pos;
  DI void operator()(const AccT& acc, const pg8::Unit& u, int wr, int wc, int fr, int fq) const {
    EPI_ROWLOOP {
      const long row = EPI_ROW;
      float rs; { const f32x4 pv = *(const f32x4*)(ssq + row * 16 + fq * 4); float t = (pv[0] + pv[1]) + (pv[2] + pv[3]); t += __shfl_xor(t, 16); t += __shfl_xor(t, 32); rs = rsqrtf(t * (1.f / 1024.f) + 1e-6f); }
      float ssb[2];
#pragma unroll
      for (int bj = 0; bj < 2; ++bj) {
        const f32x4 a = acc[ai][bj][m][0] * rs, b = acc[ai][bj][m][1] * rs;
        *(u32x4*)(proj + row * EV_LD + u.pn * 256 + bj * 128 + wc * 32 + fq * 8) = pack8v(a, b);
        ssb[bj] = a[0] * a[0] + a[1] * a[1] + a[2] * a[2] + a[3] * a[3] + b[0] * b[0] + b[1] * b[1] + b[2] * b[2] + b[3] * b[3];
        if (bj == 1 && u.pn == 8 && wc == 0) {
          const float ps = (float)pos[row];
          f32x4 o1, o2;
#pragma unroll
          for (int j = 0; j < 4; ++j) { float sn, cs; rope_ang(ps, fq * 4 + j, sn, cs); o1[j] = a[j] * cs - b[j] * sn; o2[j] = b[j] * cs + a[j] * sn; }
          u32x2 w1, w2; w1.x = pk2(o1[0], o1[1]); w1.y = pk2(o1[2], o1[3]); w2.x = pk2(o2[0], o2[1]); w2.y = pk2(o2[2], o2[3]);
          const int bb = (int)(row / S), s = (int)(row % S);
#pragma unroll
          for (int h = 0; h < 8; ++h) { bf16_t* d = kf + ((long)(bb * 8 + h) * S + s) * 96 + 64 + fq * 4; *(u32x2*)d = w1; *(u32x2*)(d + 16) = w2; }
        }
      }
      if (u.pn >= 6) {
        float ss = (u.pn == 8) ? ssb[0] : ssb[0] + ssb[1];
        ss += __shfl_xor(ss, 16); ss += __shfl_xor(ss, 32);
        if (fq == 0) { if (u.pn == 6) ssq_kv[row * 4 + wc] = ss; else ssq_q[row * 8 + (u.pn - 7) * 4 + wc] = ss; }
      }
    }
  }
};
struct EpiQ {
  bf16_t* q; const float* ssq; const int* pos;
  DI void operator()(const AccT& acc, const pg8::Unit& u, int wr, int wc, int fr, int fq) const {
    const float QS = 0.10206207261596575f * 1.4426950408889634f;
    EPI_ROWLOOP {
      const long row = EPI_ROW;
      float rs; { const f32x2 pv = *(const f32x2*)(ssq + row * 8 + fq * 2); float t = pv[0] + pv[1]; t += __shfl_xor(t, 16); t += __shfl_xor(t, 32); rs = rsqrtf(t * (1.f / 384.f) + 1e-6f) * QS; }
#pragma unroll
      for (int bj = 0; bj < 2; ++bj) {
        const int c0 = u.pn * 256 + bj * 128 + wc * 32;
        const f32x4 a = acc[ai][bj][m][0] * rs, b = acc[ai][bj][m][1] * rs;
        if ((c0 % 96) == 64) {
          const float ps = (float)pos[row];
          f32x4 o1, o2;
#pragma unroll
          for (int j = 0; j < 4; ++j) { float sn, cs; rope_ang(ps, fq * 4 + j, sn, cs); o1[j] = a[j] * cs - b[j] * sn; o2[j] = b[j] * cs + a[j] * sn; }
          u32x2 w1, w2; w1.x = pk2(o1[0], o1[1]); w1.y = pk2(o1[2], o1[3]); w2.x = pk2(o2[0], o2[1]); w2.y = pk2(o2[2], o2[3]);
          bf16_t* d = q + row * 768 + c0 + fq * 4; *(u32x2*)d = w1; *(u32x2*)(d + 16) = w2;
        } else {
          *(u32x4*)(q + row * 768 + c0 + fq * 8) = pack8v(a, b);
        }
      }
      __builtin_amdgcn_sched_barrier(0);
    }
  }
};
struct EpiKV {
  bf16_t* kf; bf16_t* vv; const float* ssq;
  DI void operator()(const AccT& acc, const pg8::Unit& u, int wr, int wc, int fr, int fq) const {
    EPI_ROWLOOP {
      const long row = EPI_ROW;
      float rs; { float t = ssq[row * 4 + fq]; t += __shfl_xor(t, 16); t += __shfl_xor(t, 32); rs = rsqrtf(t * (1.f / 256.f) + 1e-6f); }
      const int bb = (int)(row / S), s = (int)(row % S);
#pragma unroll
      for (int bj = 0; bj < 2; ++bj) {
        const int kcol = (u.pn & 1) * 256 + bj * 128 + wc * 32 + fq * 8, h = kcol >> 6, d = kcol & 63;
        const f32x4 a = acc[ai][bj][m][0] * rs, b = acc[ai][bj][m][1] * rs;
        bf16_t* dst = (u.pn < 2) ? (kf + ((long)(bb * 8 + h) * S + s) * 96 + d) : (vv + ((long)(bb * 8 + h) * S + s) * 64 + d);
        *(u32x4*)dst = pack8v(a, b);
      }
      __builtin_amdgcn_sched_barrier(0);
    }
  }
};
struct EpiProjOdd {
  bf16_t* proj; float* loga; const float* gb; const float* ssq;
  DI void operator()(const AccT& acc, const pg8::Unit& u, int wr, int wc, int fr, int fq) const {
    EPI_ROWLOOP {
      const long row = EPI_ROW;
      float rs; { const f32x4 pv = *(const f32x4*)(ssq + row * 16 + fq * 4); float t = (pv[0] + pv[1]) + (pv[2] + pv[3]); t += __shfl_xor(t, 16); t += __shfl_xor(t, 32); rs = rsqrtf(t * (1.f / 1024.f) + 1e-6f); }
#pragma unroll
      for (int bj = 0; bj < 2; ++bj) {
        const int cl = bj * 128 + wc * 32 + fq * 8;
        f32x4 a = acc[ai][bj][m][0] * rs, b = acc[ai][bj][m][1] * rs;
        if (u.pn < 10) {
          *(u32x4*)(proj + row * OD_LD + u.pn * 256 + cl) = pack8v(a, b);
        } else {
          const f32x4 g0 = *(const f32x4*)(gb + cl), g1 = *(const f32x4*)(gb + cl + 4);
#pragma unroll
          for (int j = 0; j < 4; ++j) {
            const float z0 = a[j] + g0[j], z1 = b[j] + g1[j];
            a[j] = (fminf(z0, 0.f) - 0.6931471805599453f * __builtin_amdgcn_logf(1.f + fexp(-fabsf(z0)))) * 0.0625f;
            b[j] = (fminf(z1, 0.f) - 0.6931471805599453f * __builtin_amdgcn_logf(1.f + fexp(-fabsf(z1)))) * 0.0625f;
          }
          *(f32x4*)(loga + row * 256 + cl) = a; *(f32x4*)(loga + row * 256 + cl + 4) = b;
        }
      }
      __builtin_amdgcn_sched_barrier(0);
    }
  }
};
template <class Epi>
DI void run_gemm(const bf16_t* A, int lda, const bf16_t* Bt, int K, int nN, const Epi& E) {
  pg8::Gemm g; g.A = A; g.Bt = Bt; g.lda = lda; g.K = K; g.nN = nN;
  pg8::StaticOrder S; S.init(T, nN, gridDim.x, blockIdx.x);
  pg8::gemm_phase<Epi, true>(g, S, E);
}

DI void conv_even(const bf16_t* __restrict__ proj, const float* __restrict__ cw, bf16_t* __restrict__ mix) {
#pragma unroll 2
  for (long it = (long)blockIdx.x * blockDim.x + tidx(); it < (long)T * 64; it += (long)gridDim.x * blockDim.x) {
    const long tok = it >> 6; const int c8 = (int)(it & 63) * 8; const int s = (int)(tok % S);
    const bf16_t* pr = proj + tok * EV_LD;
    const u32x4 gb = *(const u32x4*)(pr + c8);
    float accv[8];
#pragma unroll
    for (int e = 0; e < 8; ++e) accv[e] = 0.f;
#pragma unroll
    for (int k = 0; k < 3; ++k) {
      const int back = 2 - k;
      if (s >= back) {
        const u32x4 gc = *(const u32x4*)(pr - (long)back * EV_LD + 512 + c8);
        const u32x4 uu = *(const u32x4*)(pr - (long)back * EV_LD + 1024 + c8);
        const f32x4 w0 = *(const f32x4*)(cw + k * 512 + c8), w1 = *(const f32x4*)(cw + k * 512 + c8 + 4);
#pragma unroll
        for (int e = 0; e < 4; ++e) {
          accv[2 * e] += (e < 2 ? w0[2 * e] : w1[2 * e - 4]) * bflo(gc[e]) * bflo(uu[e]);
          accv[2 * e + 1] += (e < 2 ? w0[2 * e + 1] : w1[2 * e - 3]) * bfhi(gc[e]) * bfhi(uu[e]);
        }
      }
    }
    u32x4 o;
#pragma unroll
    for (int e = 0; e < 4; ++e) o[e] = pk2(accv[2 * e] * bflo(gb[e]), accv[2 * e + 1] * bfhi(gb[e]));
    *(u32x4*)(mix + tok * 1024 + c8) = o;
  }
}

constexpr int AT_KSTR = 208, AT_VSTR = 264, AT_KBUF = 128 * AT_KSTR, AT_VBUF = 64 * AT_VSTR, AT_VOFF = 2 * AT_KBUF;
DI void attn_qtile(const bf16_t* __restrict__ q, const bf16_t* __restrict__ kf, const bf16_t* __restrict__ vv, bf16_t* __restrict__ mix, int b, int h, int qt) {
  const int tid = tidx(), wid = __builtin_amdgcn_readfirstlane(tid >> 6), lane = tid & 63, r = lane & 31, hh = lane >> 5;
  const int q0 = qt * 256;
  const int qrow = q0 + wid * 32 + r;
  const int wave_qmin = q0 + wid * 32, wave_qmax = wave_qmin + 31;
  const long bh = (long)b * 8 + h;
  bf16x8 qf[6];
  {
    const bf16_t* qp = q + ((long)b * S + qrow) * 768 + h * 96 + hh * 8;
#pragma unroll
    for (int ks = 0; ks < 6; ++ks) qf[ks] = *(const bf16x8*)(qp + ks * 16);
  }
  f32x16 o0, o1;
#pragma unroll
  for (int i = 0; i < 16; ++i) { o0[i] = 0.f; o1[i] = 0.f; }
  float mrun = 0.f, lrun = 0.f;
  f32x16 negm;
#pragma unroll
  for (int i = 0; i < 16; ++i) negm[i] = 0.f;
  const int nkt = (q0 + 256) / 128;
  const bf16_t* kbase = kf + bh * S * 96;
  const bf16_t* vbase = vv + bh * S * 64;
  const int vkey = tid & 127, vdc = tid >> 7;
  u32x4 kr[3], vr[2];
  __syncthreads();
#define AT_LOAD(k0) do { \
    const bf16_t* kb_ = kbase + (long)(k0) * 96; \
    _Pragma("unroll") for (int i_ = 0; i_ < 3; ++i_) kr[i_] = *(const u32x4*)(kb_ + (long)(tid + 512 * i_) * 8); \
    _Pragma("unroll") for (int i_ = 0; i_ < 2; ++i_) vr[i_] = *(const u32x4*)(vbase + (long)((k0) + vkey) * 64 + (vdc + 4 * i_) * 8); } while (0)
#define AT_WRITE(buf) do { \
    _Pragma("unroll") for (int i_ = 0; i_ < 3; ++i_) { const int c = tid + 512 * i_; *(u32x4*)(g_shm + (buf) * AT_KBUF + (c / 12) * AT_KSTR + (c % 12) * 16) = kr[i_]; } \
    _Pragma("unroll") for (int i_ = 0; i_ < 2; ++i_) { char* vb = g_shm + AT_VOFF + (buf) * AT_VBUF + ((vdc + 4 * i_) * 8) * AT_VSTR + vkey * 2; \
      _Pragma("unroll") for (int e = 0; e < 4; ++e) { \
        *(bf16_t*)(vb + (2 * e) * AT_VSTR) = (bf16_t)(vr[i_][e] & 0xffffu); \
        *(bf16_t*)(vb + (2 * e + 1) * AT_VSTR) = (bf16_t)(vr[i_][e] >> 16); } } } while (0)
  AT_LOAD(0);
  AT_WRITE(0);
  __syncthreads();
  for (int kt = 0; kt < nkt; ++kt) {
    if (kt + 1 < nkt) AT_LOAD((kt + 1) * 128);
#pragma unroll
    for (int sb = 0; sb < 2; ++sb) {
      const int k0 = kt * 128 + sb * 64;
      if (k0 <= wave_qmax) {
        const char* Kb = g_shm + (kt & 1) * AT_KBUF + (sb * 64 + r) * AT_KSTR + hh * 16;
        const char* Vb = g_shm + AT_VOFF + (kt & 1) * AT_VBUF + r * AT_VSTR + sb * 128 + hh * 8;
        f32x16 s0, s1;
#pragma unroll
        for (int ks = 0; ks < 6; ++ks) {
          const bf16x8 a0 = *(const bf16x8*)(Kb + ks * 32);
          const bf16x8 a1 = *(const bf16x8*)(Kb + 32 * AT_KSTR + ks * 32);
          s0 = MFMA32(a0, qf[ks], ks == 0 ? negm : s0);
          s1 = MFMA32(a1, qf[ks], ks == 0 ? negm : s1);
        }
        if (k0 + 63 > wave_qmin) {
#pragma unroll
          for (int i = 0; i < 16; ++i) {
            const int key = k0 + crow(i, hh);
            if (key > qrow) s0[i] = -INFINITY;
            if (key + 32 > qrow) s1[i] = -INFINITY;
          }
        }
        float la0 = 0.f, la1 = 0.f, la2 = 0.f, la3 = 0.f;
#pragma unroll
        for (int i = 0; i < 16; i += 2) {
          s0[i] = __builtin_amdgcn_exp2f(s0[i]); s0[i + 1] = __builtin_amdgcn_exp2f(s0[i + 1]);
          s1[i] = __builtin_amdgcn_exp2f(s1[i]); s1[i + 1] = __builtin_amdgcn_exp2f(s1[i + 1]);
          la0 += s0[i]; la1 += s0[i + 1]; la2 += s1[i]; la3 += s1[i + 1];
        }
        const float ls = (la0 + la1) + (la2 + la3);
        lrun += ls;
        bf16x8 pb[2][2];
        pb[0][0] = pack8(s0, 0); pb[0][1] = pack8(s0, 1); pb[1][0] = pack8(s1, 0); pb[1][1] = pack8(s1, 1);
#pragma unroll
        for (int kb = 0; kb < 2; ++kb)
#pragma unroll
          for (int s2 = 0; s2 < 2; ++s2) {
            const int kofs = (32 * kb + 16 * s2) * 2;
            const s16x4 lo0 = *(const s16x4*)(Vb + kofs), hi0 = *(const s16x4*)(Vb + kofs + 16);
            const s16x4 lo1 = *(const s16x4*)(Vb + 32 * AT_VSTR + kofs), hi1 = *(const s16x4*)(Vb + 32 * AT_VSTR + kofs + 16);
            const bf16x8 va0 = __builtin_shufflevector(lo0, hi0, 0, 1, 2, 3, 4, 5, 6, 7);
            const bf16x8 va1 = __builtin_shufflevector(lo1, hi1, 0, 1, 2, 3, 4, 5, 6, 7);
            o0 = MFMA32(va0, pb[kb][s2], o0);
            o1 = MFMA32(va1, pb[kb][s2], o1);
          }
        if (__any(ls > 4096.f)) {
          const float big = fmaxf(ls, __shfl_xor(ls, 32));
          const float delta = (big > 4096.f) ? floorf(__builtin_amdgcn_logf(big)) : 0.f;
          const float alpha = __builtin_amdgcn_exp2f(-delta);
          lrun *= alpha; mrun += delta;
#pragma unroll
          for (int i = 0; i < 16; ++i) { o0[i] *= alpha; o1[i] *= alpha; negm[i] = -mrun; }
        }
      }
    }
    if (kt + 1 < nkt) AT_WRITE((kt + 1) & 1);
    __syncthreads();
  }
#undef AT_WRITE
#undef AT_LOAD
  const float ltot = lrun + __shfl_xor(lrun, 32);
  const float inv = 1.f / ltot;
  bf16_t* op = mix + ((long)b * S + qrow) * 1024 + 512 + h * 64;
#pragma unroll
  for (int g4 = 0; g4 < 4; ++g4) {
    const int dv = 8 * g4 + 4 * hh;
    u32x2 a, c;
    a.x = pk2(o0[4 * g4] * inv, o0[4 * g4 + 1] * inv); a.y = pk2(o0[4 * g4 + 2] * inv, o0[4 * g4 + 3] * inv);
    c.x = pk2(o1[4 * g4] * inv, o1[4 * g4 + 1] * inv); c.y = pk2(o1[4 * g4 + 2] * inv, o1[4 * g4 + 3] * inv);
    *(u32x2*)(op + dv) = a; *(u32x2*)(op + 32 + dv) = c;
  }
}
DI void phase_attn(const bf16_t* q, const bf16_t* kf, const bf16_t* vv, bf16_t* mix) {
  for (int u = blockIdx.x; u < 512; u += gridDim.x) {
    const int xcd = u & 7, idx = u >> 3, bhh = (idx >> 3) * 8 + xcd, pi = idx & 7;
    const int b = bhh >> 3, h = bhh & 7;
    attn_qtile(q, kf, vv, mix, b, h, 15 - pi);
    attn_qtile(q, kf, vv, mix, b, h, pi);
  }
}

constexpr int GL_STR = 144;
DI float gla_cum(const float* __restrict__ loga, long t0, int hd, float (&cum)[8]) {
  const int tid = tidx(), dk = tid & 63, seg = tid >> 6;
  float* segs = (float*)g_shm;
#pragma unroll
  for (int e = 0; e < 8; ++e) cum[e] = loga[(t0 + seg * 8 + e) * 256 + hd * 64 + dk];
#pragma unroll
  for (int e = 1; e < 8; ++e) cum[e] += cum[e - 1];
  segs[seg * 64 + dk] = cum[7];
  __syncthreads();
  float off = 0.f, tot = 0.f;
#pragma unroll
  for (int s = 0; s < 8; ++s) { const float v = segs[s * 64 + dk]; tot += v; if (s < seg) off += v; }
#pragma unroll
  for (int e = 0; e < 8; ++e) cum[e] += off;
  return tot;
}
DI void gla_stage_vT(const bf16_t* __restrict__ proj, long t0, int hd, char* vT) {
  const int tid = tidx(), dv = tid & 127, jq = tid >> 7;
  unsigned w[8];
#pragma unroll
  for (int e = 0; e < 8; ++e) {
    const unsigned a = proj[(t0 + jq * 16 + 2 * e) * OD_LD + 512 + hd * 128 + dv];
    const unsigned b = proj[(t0 + jq * 16 + 2 * e + 1) * OD_LD + 512 + hd * 128 + dv];
    w[e] = a | (b << 16);
  }
  *(u32x4*)(vT + dv * GL_STR + jq * 32) = (u32x4){w[0], w[1], w[2], w[3]};
  *(u32x4*)(vT + dv * GL_STR + jq * 32 + 16) = (u32x4){w[4], w[5], w[6], w[7]};
}
DI void gla_g1_unit(const bf16_t* __restrict__ proj, const float* __restrict__ loga, float* __restrict__ states, float* __restrict__ decay, int unit) {
  const int tid = tidx(), wid = tid >> 6, lane = tid & 63, r = lane & 31, hh = lane >> 5, dk = tid & 63, seg = tid >> 6;
  const int n = unit & 63, hd = (unit >> 6) & 3, b = unit >> 8;
  const long t0 = (long)b * S + n * 64;
  char* koT = g_shm + 2048; char* vT = g_shm + 11264;
  __syncthreads();
  float cum[8];
  const float tot = gla_cum(loga, t0, hd, cum);
  {
    float ko[8];
#pragma unroll
    for (int e = 0; e < 8; ++e) ko[e] = bf2f(proj[(t0 + seg * 8 + e) * OD_LD + 256 + hd * 64 + dk]) * fexp(tot - cum[e]);
    u32x4 o; o.x = pk2(ko[0], ko[1]); o.y = pk2(ko[2], ko[3]); o.z = pk2(ko[4], ko[5]); o.w = pk2(ko[6], ko[7]);
    *(u32x4*)(koT + dk * GL_STR + seg * 16) = o;
    if (seg == 0) decay[(long)unit * 64 + dk] = fexp(tot);
  }
  gla_stage_vT(proj, t0, hd, vT);
  __syncthreads();
  const int dvb = wid >> 1, dkb = wid & 1;
  f32x16 acc;
#pragma unroll
  for (int i = 0; i < 16; ++i) acc[i] = 0.f;
#pragma unroll
  for (int ks = 0; ks < 4; ++ks) {
    const bf16x8 a = *(const bf16x8*)(vT + (32 * dvb + r) * GL_STR + ks * 32 + hh * 16);
    const bf16x8 bb = *(const bf16x8*)(koT + (32 * dkb + r) * GL_STR + ks * 32 + hh * 16);
    acc = MFMA32(a, bb, acc);
  }
  float* st = states + (long)unit * 8192;
#pragma unroll
  for (int i = 0; i < 16; ++i) st[(32 * dvb + crow(i, hh)) * 64 + 32 * dkb + r] = acc[i];
}
DI void gla_g3_unit(const bf16_t* __restrict__ proj, const float* __restrict__ loga, const float* __restrict__ states, const float* __restrict__ gng,
                    bf16_t* __restrict__ mix, int unit) {
  const int tid = tidx(), wid = tid >> 6, lane = tid & 63, r = lane & 31, hh = lane >> 5, dk = tid & 63, seg = tid >> 6;
  const int n = unit & 63, hd = (unit >> 6) & 3, b = unit >> 8;
  const long t0 = (long)b * S + n * 64;
  char* qin = g_shm + 2048; char* kin = g_shm + 11264; char* vT = g_shm + 20480; char* sT = g_shm + 38912; float* ssp = (float*)(g_shm + 57344);
  __syncthreads();
  float cum[8];
  (void)gla_cum(loga, t0, hd, cum);
#pragma unroll
  for (int e = 0; e < 8; ++e) {
    const int tok = seg * 8 + e;
    const float qv = bf2f(proj[(t0 + tok) * OD_LD + hd * 64 + dk]) * 0.125f * fexp(cum[e]);
    const float kv = bf2f(proj[(t0 + tok) * OD_LD + 256 + hd * 64 + dk]) * fexp(-cum[e]);
    *(bf16_t*)(qin + tok * GL_STR + dk * 2) = f2bf(qv);
    *(bf16_t*)(kin + tok * GL_STR + dk * 2) = f2bf(kv);
  }
  gla_stage_vT(proj, t0, hd, vT);
  {
    const int dv = tid >> 2, dq = tid & 3;
    const float* sp = states + (long)unit * 8192 + dv * 64 + dq * 16;
    const f32x4 a = *(const f32x4*)sp, c = *(const f32x4*)(sp + 4), d = *(const f32x4*)(sp + 8), f = *(const f32x4*)(sp + 12);
    *(u32x4*)(sT + dv * GL_STR + dq * 32) = (u32x4){pk2(a[0], a[1]), pk2(a[2], a[3]), pk2(c[0], c[1]), pk2(c[2], c[3])};
    *(u32x4*)(sT + dv * GL_STR + dq * 32 + 16) = (u32x4){pk2(d[0], d[1]), pk2(d[2], d[3]), pk2(f[0], f[1]), pk2(f[2], f[3])};
  }
  __syncthreads();
  const int ib = wid >> 2, dvb = wid & 3;
  f32x16 o;
#pragma unroll
  for (int i = 0; i < 16; ++i) o[i] = 0.f;
  bf16x8 qfr[4];
#pragma unroll
  for (int ks = 0; ks < 4; ++ks) qfr[ks] = *(const bf16x8*)(qin + (32 * ib + r) * GL_STR + ks * 32 + hh * 16);
#pragma unroll
  for (int ks = 0; ks < 4; ++ks) {
    const bf16x8 a = *(const bf16x8*)(sT + (32 * dvb + r) * GL_STR + ks * 32 + hh * 16);
    o = MFMA32(a, qfr[ks], o);
  }
#pragma unroll
  for (int jb = 0; jb < 2; ++jb) {
    if (jb <= ib) {
      f32x16 at;
#pragma unroll
      for (int i = 0; i < 16; ++i) at[i] = 0.f;
#pragma unroll
      for (int ks = 0; ks < 4; ++ks) {
        const bf16x8 a = *(const bf16x8*)(kin + (32 * jb + r) * GL_STR + ks * 32 + hh * 16);
        at = MFMA32(a, qfr[ks], at);
      }
      if (jb == ib) {
#pragma unroll
        for (int i = 0; i < 16; ++i) if (crow(i, hh) > r) at[i] = 0.f;
      }
      const bf16x8 p0 = pack8(at, 0), p1 = pack8(at, 1);
      {
        const char* vb = vT + (32 * dvb + r) * GL_STR + (32 * jb + 4 * hh) * 2;
        const s16x4 lo0 = *(const s16x4*)(vb), hi0 = *(const s16x4*)(vb + 16);
        const s16x4 lo1 = *(const s16x4*)(vb + 32), hi1 = *(const s16x4*)(vb + 48);
        o = MFMA32(__builtin_shufflevector(lo0, hi0, 0, 1, 2, 3, 4, 5, 6, 7), p0, o);
        o = MFMA32(__builtin_shufflevector(lo1, hi1, 0, 1, 2, 3, 4, 5, 6, 7), p1, o);
      }
    }
  }
  float ss = 0.f;
#pragma unroll
  for (int i = 0; i < 16; ++i) ss += o[i] * o[i];
  ss += __shfl_xor(ss, 32);
  if (hh == 0) ssp[(32 * ib + r) * 4 + dvb] = ss;
  __syncthreads();
  const f32x4 pp = *(const f32x4*)(ssp + (32 * ib + r) * 4);
  const float rs = rsqrtf((pp[0] + pp[1] + pp[2] + pp[3]) * (1.f / 128.f) + 1e-6f);
  const long tok = t0 + 32 * ib + r;
#pragma unroll
  for (int g4 = 0; g4 < 4; ++g4) {
    const int dv = 32 * dvb + 8 * g4 + 4 * hh;
    const u32x2 gt = *(const u32x2*)(proj + tok * OD_LD + 1024 + hd * 128 + dv);
    const f32x4 gn = *(const f32x4*)(gng + dv);
    float gv[4] = {bflo(gt.x), bfhi(gt.x), bflo(gt.y), bfhi(gt.y)};
    float ov[4];
#pragma unroll
    for (int e = 0; e < 4; ++e) ov[e] = o[4 * g4 + e] * rs * gn[e] * (gv[e] * sigmoidf_(gv[e]));
    u32x2 w; w.x = pk2(ov[0], ov[1]); w.y = pk2(ov[2], ov[3]);
    *(u32x2*)(mix + tok * 1024 + hd * 128 + dv) = w;
  }
}
constexpr int LX_STR = 1040;
DI void lru_g1_unit(const Params& p, int j, const bf16_t* __restrict__ proj, bf16_t* __restrict__ hl, bf16_t* __restrict__ Pp, float* __restrict__ lruA,
                    float* __restrict__ lruB, const bf16_t* __restrict__ lw, int unit) {
  const int tid = tidx(), wid = tid >> 6, lane = tid & 63, r = lane & 31, hh = lane >> 5;
  const int n = unit & 63, b = unit >> 6;
  const long t0 = (long)b * S + n * 64;
  char* xraw = g_shm;
  char* xcb = g_shm;
  __syncthreads();
  {
    u32x4 v[9];
#pragma unroll
    for (int i = 0; i < 9; ++i) {
      const int q = tid + 512 * i, row = q >> 6, c16 = q & 63;
      v[i] = (u32x4){0u, 0u, 0u, 0u};
      if (row < 67 && (n > 0 || row >= 3)) v[i] = *(const u32x4*)(proj + (t0 - 3 + row) * OD_LD + 1536 + c16 * 8);
    }
#pragma unroll
    for (int i = 0; i < 9; ++i) {
      const int q = tid + 512 * i, row = q >> 6, c16 = q & 63;
      if (row < 67) *(u32x4*)(xraw + row * LX_STR + c16 * 16) = v[i];
    }
  }
  __syncthreads();
  {
    const int c = tid;
    const float* cw = p.lru_conv_w + j * 4 * 512;
    const float w0 = cw[c], w1 = cw[512 + c], w2 = cw[1024 + c], w3 = cw[1536 + c], cb = p.lru_conv_b[j * 512 + c];
    float xm3 = bf2f(*(const bf16_t*)(xraw + 0 * LX_STR + c * 2)), xm2 = bf2f(*(const bf16_t*)(xraw + 1 * LX_STR + c * 2)), xm1 = bf2f(*(const bf16_t*)(xraw + 2 * LX_STR + c * 2));
#pragma unroll 8
    for (int t = 0; t < 64; ++t) {
      const float xt = bf2f(*(const bf16_t*)(xraw + (t + 3) * LX_STR + c * 2));
      *(bf16_t*)(xcb + t * LX_STR + c * 2) = f2bf(cb + w0 * xm3 + w1 * xm2 + w2 * xm1 + w3 * xt);
      xm3 = xm2; xm2 = xm1; xm1 = xt;
    }
  }
  __syncthreads();
  const int blk = wid;
  char* otile = g_shm + 66560 + wid * 8192;
#pragma unroll 1
  for (int cbk = 0; cbk < 2; ++cbk) {
    const int c = blk * 64 + 32 * cbk + r;
    bf16x8 wfa[4], wfi[4];
    {
      const bf16_t* wa = lw + ((long)((0 * 2 + j) * 8 + blk) * 64 + 32 * cbk + r) * 64 + 8 * hh;
      const bf16_t* wi = lw + ((long)((1 * 2 + j) * 8 + blk) * 64 + 32 * cbk + r) * 64 + 8 * hh;
#pragma unroll
      for (int ks = 0; ks < 4; ++ks) { wfa[ks] = *(const bf16x8*)(wa + 16 * ks); wfi[ks] = *(const bf16x8*)(wi + 16 * ks); }
    }
    f32x16 aA[2], aI[2];
#pragma unroll
    for (int rb = 0; rb < 2; ++rb) {
#pragma unroll
      for (int i = 0; i < 16; ++i) { aA[rb][i] = 0.f; aI[rb][i] = 0.f; }
#pragma unroll
      for (int ks = 0; ks < 4; ++ks) {
        const bf16x8 A = *(const bf16x8*)(xcb + (32 * rb + r) * LX_STR + (blk * 64 + 16 * ks + 8 * hh) * 2);
        aA[rb] = MFMA32(A, wfa[ks], aA[rb]);
        aI[rb] = MFMA32(A, wfi[ks], aI[rb]);
      }
    }
    const float ba = p.lru_b_a[j * 512 + c], bi = p.lru_b_i[j * 512 + c];
    const float lam = p.lru_lam[j * 512 + c];
    const float sp = fmaxf(-lam, 0.f) + log1pf(__expf(-fabsf(lam)));
#pragma unroll
    for (int rb = 0; rb < 2; ++rb)
#pragma unroll
      for (int i = 0; i < 16; ++i) {
        const int tok = 32 * rb + crow(i, hh);
        const float xcv = bf2f(*(const bf16_t*)(xcb + tok * LX_STR + c * 2));
        const float rg = sigmoidf_(aA[rb][i] + ba), ig = sigmoidf_(aI[rb][i] + bi);
        const float la = -8.f * rg * sp;
        const float a = fexp(la);
        const float x2 = 2.f * la;
        const float om = (x2 > -0.25f) ? -x2 * (1.f + x2 * (0.5f + x2 * ((1.f / 6.f) + x2 * ((1.f / 24.f) + x2 * (1.f / 120.f))))) : 1.f - a * a;
        const float mult = __builtin_amdgcn_sqrtf(fmaxf(om, 0.f));
        aA[rb][i] = a; aI[rb][i] = mult * ig * xcv;
      }
    float gA[8], gB[8], oA[8], oB[8];
#pragma unroll
    for (int gi = 0; gi < 8; ++gi) {
      float A = 1.f, B = 0.f;
#pragma unroll
      for (int e = 0; e < 4; ++e) { const float a = aA[gi >> 2][4 * (gi & 3) + e], x = aI[gi >> 2][4 * (gi & 3) + e]; B = a * B + x; A *= a; }
      gA[gi] = A; gB[gi] = B;
      oA[gi] = __shfl_xor(A, 32); oB[gi] = __shfl_xor(B, 32);
    }
    float h = 0.f, P = 1.f, hs[8], Ps[8];
#pragma unroll
    for (int gi = 0; gi < 8; ++gi) {
      const float A0 = hh ? oA[gi] : gA[gi], B0 = hh ? oB[gi] : gB[gi];
      const float A1 = hh ? gA[gi] : oA[gi], B1 = hh ? gB[gi] : oB[gi];
      const float h1 = A0 * h + B0, P1 = P * A0;
      hs[gi] = hh ? h1 : h; Ps[gi] = hh ? P1 : P;
      h = A1 * h1 + B1; P = P1 * A1;
    }
#pragma unroll
    for (int gi = 0; gi < 8; ++gi) {
      float hc = hs[gi], Pc = Ps[gi];
#pragma unroll
      for (int e = 0; e < 4; ++e) {
        const float a = aA[gi >> 2][4 * (gi & 3) + e], x = aI[gi >> 2][4 * (gi & 3) + e];
        hc = a * hc + x; Pc *= a;
        const int tk = 32 * (gi >> 2) + 8 * (gi & 3) + 4 * hh + e;
        *(bf16_t*)(otile + tk * 64 + r * 2) = f2bf(hc); *(bf16_t*)(otile + 4096 + tk * 64 + r * 2) = f2bf(Pc);
      }
    }
    __builtin_amdgcn_wave_barrier(); asm volatile("s_waitcnt lgkmcnt(0)" ::: "memory");
#pragma unroll
    for (int i = 0; i < 8; ++i) {
      const int rw = (lane >> 2) + 16 * i, pc = lane & 3, arr = rw >> 6, tk = rw & 63;
      const u32x4 v = *(const u32x4*)(otile + rw * 64 + pc * 16);
      bf16_t* dst = (arr ? Pp : hl) + (t0 + tk) * 512 + blk * 64 + 32 * cbk + pc * 8;
      *(u32x4*)dst = v;
    }
    __builtin_amdgcn_wave_barrier(); asm volatile("s_waitcnt lgkmcnt(0)" ::: "memory");
    if (hh == 0) { lruA[(long)unit * 512 + c] = P; lruB[(long)unit * 512 + c] = h; }
  }
}
DI float gelu_tanh(float y) {
  const float u = 0.7978845608028654f * (y + 0.044715f * y * y * y);
  const float e = fexp(2.f * u);
  const float th = 1.f - 2.f * frcp(e + 1.f);
  return 0.5f * y * (1.f + th);
}
DI void lru_g3(const bf16_t* __restrict__ proj, const bf16_t* __restrict__ hl, const bf16_t* __restrict__ Pp, const float* __restrict__ hin, bf16_t* __restrict__ mix) {
  const long gstride = (long)gridDim.x * blockDim.x;
  for (long it0 = (long)blockIdx.x * blockDim.x + tidx(); it0 < (long)T * 64; it0 += 4 * gstride) {
    u32x4 y[4], hv[4], pv[4]; f32x4 h0[4], h1[4];
#pragma unroll
    for (int k = 0; k < 4; ++k) {
      const long it = it0 + k * gstride;
      if (it < (long)T * 64) {
        const long tok = it >> 6; const int c8 = (int)(it & 63) * 8;
        const int b = (int)(tok / S), n = (int)(tok % S) >> 6;
        y[k] = *(const u32x4*)(proj + tok * OD_LD + 2048 + c8);
        hv[k] = *(const u32x4*)(hl + tok * 512 + c8);
        pv[k] = *(const u32x4*)(Pp + tok * 512 + c8);
        const float* hp = hin + ((long)(b * 64 + n)) * 512 + c8;
        h0[k] = *(const f32x4*)hp; h1[k] = *(const f32x4*)(hp + 4);
      }
    }
#pragma unroll
    for (int k = 0; k < 4; ++k) {
      const long it = it0 + k * gstride;
      if (it < (long)T * 64) {
        const long tok = it >> 6; const int c8 = (int)(it & 63) * 8;
        u32x4 o;
#pragma unroll
        for (int e = 0; e < 4; ++e) {
          const float hi0 = (e < 2 ? h0[k][2 * e] : h1[k][2 * e - 4]), hi1 = (e < 2 ? h0[k][2 * e + 1] : h1[k][2 * e - 3]);
          const float a = gelu_tanh(bflo(y[k][e])) * (bflo(hv[k][e]) + bflo(pv[k][e]) * hi0);
          const float c = gelu_tanh(bfhi(y[k][e])) * (bfhi(hv[k][e]) + bfhi(pv[k][e]) * hi1);
          o[e] = pk2(a, c);
        }
        *(u32x4*)(mix + tok * 1024 + 512 + c8) = o;
      }
    }
  }
}
DI void phase_g2(float* __restrict__ states, const float* __restrict__ decay, const float* __restrict__ lruA, const float* __restrict__ lruB, float* __restrict__ hin) {
  const long gt = (long)blockIdx.x * blockDim.x + tidx(), gn = (long)gridDim.x * blockDim.x;
  for (long idx = gt; idx < 32L * 8192; idx += gn) {
    const int bhd = (int)(idx >> 13), e = (int)(idx & 8191), dk = e & 63;
    float s = 0.f;
    for (int n0 = 0; n0 < 64; n0 += 32) {
      float* ptr = states + ((long)(bhd * 64 + n0)) * 8192 + e;
      const float* dp = decay + (long)(bhd * 64 + n0) * 64 + dk;
      float v[32], d[32];
#pragma unroll
      for (int n = 0; n < 32; ++n) { v[n] = ptr[(long)n * 8192]; d[n] = dp[n * 64]; }
#pragma unroll
      for (int n = 0; n < 32; ++n) { const float tmp = v[n]; v[n] = s; s = d[n] * s + tmp; }
#pragma unroll
      for (int n = 0; n < 32; ++n) ptr[(long)n * 8192] = v[n];
    }
  }
  for (long idx = gt; idx < 8L * 512; idx += gn) {
    const int b = (int)(idx >> 9), c = (int)(idx & 511);
    float h = 0.f;
    for (int n = 0; n < 64; ++n) { const long o = (long)(b * 64 + n) * 512 + c; hin[o] = h; h = lruA[o] * h + lruB[o]; }
  }
}
DI void phase_final(const Params& p) {
  const int lane = tidx() & 63, gw = (blockIdx.x * blockDim.x + tidx()) >> 6, nw = (gridDim.x * blockDim.x) >> 6;
  const bf16_t* hb = (const bf16_t*)(p.ws + OFF_HB);
  for (int row = gw; row < T; row += nw) {
    const bf16_t* hr = hb + (long)row * 1024;
    float* xr = p.out + (long)row * 1024;
    float v[16]; float ss = 0.f;
#pragma unroll
    for (int i = 0; i < 2; ++i) {
      const u32x4 u = *(const u32x4*)(hr + i * 512 + lane * 8);
#pragma unroll
      for (int e = 0; e < 4; ++e) { v[i * 8 + 2 * e] = bflo(u[e]); v[i * 8 + 2 * e + 1] = bfhi(u[e]); }
    }
#pragma unroll
    for (int i = 0; i < 16; ++i) ss += v[i] * v[i];
#pragma unroll
    for (int d = 1; d < 64; d <<= 1) ss += __shfl_xor(ss, d);
    const float rs = rsqrtf(ss * (1.f / 1024.f) + 1e-6f);
#pragma unroll
    for (int i = 0; i < 2; ++i) {
      const f32x4 g0 = *(const f32x4*)(p.final_g + i * 512 + lane * 8), g1 = *(const f32x4*)(p.final_g + i * 512 + lane * 8 + 4);
      *(f32x4*)(xr + i * 512 + lane * 8) = (f32x4){v[i * 8] * rs * g0[0], v[i * 8 + 1] * rs * g0[1], v[i * 8 + 2] * rs * g0[2], v[i * 8 + 3] * rs * g0[3]};
      *(f32x4*)(xr + i * 512 + lane * 8 + 4) = (f32x4){v[i * 8 + 4] * rs * g1[0], v[i * 8 + 5] * rs * g1[1], v[i * 8 + 6] * rs * g1[2], v[i * 8 + 7] * rs * g1[3]};
    }
  }
}

constexpr int N_PHASES = 1 + 6 + 7 + 6 + 7 + 1;
DI void run_phase(const Params& p, int ph) {
  char* ws = p.ws; char* R = ws + OFF_R;
  bf16_t* hb = (bf16_t*)(ws + OFF_HB);
  float* ssqh = (float*)(ws + OFF_SSQH);
  bf16_t* mix = (bf16_t*)(R + R_MIX);
  if (ph == 0) { if (PHM(14)) for (int rp = 0; rp < (PROBE_STEP == 14 ? 2 : 1); ++rp) phase_prep(p); return; }
  if (ph == N_PHASES - 1) { if (PHM(15)) phase_final(p); return; }
  int q = ph - 1, layer = 0;
  while (true) { const int ns = (layer & 1) ? 7 : 6; if (q < ns) break; q -= ns; ++layer; }
  const int j = layer >> 1, odd = layer & 1;
  int step = q;
  if (odd && step >= 4) step -= 1; else if (odd) step += 10;
  const int reps = (step == PROBE_STEP) ? 2 : 1;
  float* H0 = (float*)(ws + OFF_SSQH); float* H1 = (float*)(ws + 500 * MB);
  float* ssqq = (float*)(ws + OFF_SSQQ); float* ssqkv = (float*)(ws + OFF_SSQKV);
  if (step == 0 && PHM(0)) {
    EpiProjEven E{(bf16_t*)(R + R_PROJ), H0, ssqkv, ssqq, (bf16_t*)(R + R_KF), p.pos};
    run_gemm(hb, 1024, (bf16_t*)(ws + OFF_EWIN) + (long)j * 2304 * 1024, 1024, 9, E);
  } else if (step == 1 && PHM(1)) {
    const bf16_t* proj = (bf16_t*)(R + R_PROJ);
    EpiQ Eq{(bf16_t*)(R + R_Q), ssqq, p.pos};
#ifndef NO_Q
    run_gemm(proj + 1792, EV_LD, (bf16_t*)(ws + OFF_WUQ) + (long)j * 768 * 384, 384, 3, Eq);
#endif
    EpiKV Ek{(bf16_t*)(R + R_KF), (bf16_t*)(R + R_V), ssqkv};
#ifndef NO_KV
    run_gemm(proj + 1536, EV_LD, (bf16_t*)(ws + OFF_WUKV) + (long)j * 1024 * 256, 256, 4, Ek);
#endif
    for (int rp = 0; rp < reps; ++rp) conv_even(proj, p.ev_conv_w + j * 3 * 512, mix);
  } else if (step == 2 && PHM(2)) {
    for (int rp = 0; rp < reps; ++rp) phase_attn((bf16_t*)(R + R_Q), (bf16_t*)(R + R_KF), (bf16_t*)(R + R_V), mix);
  } else if (step == 3 && PHM(3)) {
    EpiResid E{hb, H1};
    run_gemm(mix, 1024, (odd ? (bf16_t*)(ws + OFF_OWOUT) : (bf16_t*)(ws + OFF_EWOUT)) + (long)j * 1024 * 1024, 1024, 4, E);
  } else if (step == 4 && PHM(4)) {
    EpiMlp1 E{(bf16_t*)(R), H1};
    run_gemm(hb, 1024, (bf16_t*)(ws + OFF_W1T) + (long)layer * 4096 * 1024, 1024, 16, E);
  } else if (step == 5 && PHM(5)) {
    EpiResid E{hb, H0};
    run_gemm((bf16_t*)(R), HID_LD, (bf16_t*)(ws + OFF_W2T) + (long)layer * 4096 * 1024, 4096, 4, E);
  } else if (step == 10 && PHM(10)) {
    EpiProjOdd E{(bf16_t*)(R + R_PROJ), (float*)(R + R_LOGA), p.gate_b + j * 256, H0};
    run_gemm(hb, 1024, (bf16_t*)(ws + OFF_OWIN) + (long)j * 2816 * 1024, 1024, 11, E);
  } else if (step == 11 && PHM(11)) {
    const bf16_t* proj = (bf16_t*)(R + R_PROJ);
    for (int rp = 0; rp < reps; ++rp)
    for (int u = blockIdx.x; u < 512; u += gridDim.x)
      lru_g1_unit(p, j, proj, (bf16_t*)p.out, (bf16_t*)p.out + (long)T * 512, (float*)(R + R_LRUA), (float*)(R + R_LRUB), (const bf16_t*)(ws + OFF_LRUW), u);
    for (int rp = 0; rp < (PROBE_STEP == 21 ? 2 : 1); ++rp)
    for (int u = blockIdx.x; u < 2048; u += gridDim.x)
      gla_g1_unit(proj, (float*)(R + R_LOGA), (float*)(R + R_STATES), (float*)(R + R_DECAY), u);
  } else if (step == 12 && PHM(12)) {
    phase_g2((float*)(R + R_STATES), (float*)(R + R_DECAY), (float*)(R + R_LRUA), (float*)(R + R_LRUB), (float*)(R + R_LRUH));
  } else if (step == 13 && PHM(13)) {
    const bf16_t* proj = (bf16_t*)(R + R_PROJ);
    for (int rp = 0; rp < reps; ++rp)
    for (int u = blockIdx.x; u < 2048; u += gridDim.x)
      gla_g3_unit(proj, (float*)(R + R_LOGA), (float*)(R + R_STATES), p.gla_norm_g + j * 128, mix, u);
    lru_g3(proj, (bf16_t*)p.out, (bf16_t*)p.out + (long)T * 512, (float*)(R + R_LRUH), mix);
  }
}

__global__ void __launch_bounds__(512) fwd_megakernel(Params p, int lo, int hi, int probe_ph) {
  cg::grid_group grid = cg::this_grid();
  volatile LAS unsigned* st = (volatile LAS unsigned*)(LAS char*)(g_shm + XB_LDS_OFF);
  if (threadIdx.x == 0) { st[0] = 0u; st[1] = 0u; }
  __syncthreads();
  XcdBarrier xb = xcd_barrier_post((unsigned*)p.ws, st);
  for (int ph = lo; ph < hi; ++ph) {
    const int nrep = (ph == probe_ph) ? 2 : 1;
    for (int rp = 0; rp < nrep; ++rp) {
      if (rp) xcd_barrier(xb);
      run_phase(p, ph);
    }
    if (ph + 1 < hi) {
      if (hi > N_PHASES) grid.sync();
      else xcd_barrier(xb);
    }
  }
}

extern "C" void kernel_launch(void* const* d_in, const int* in_sizes, int n_in, void* d_out, int out_size, void* d_ws, size_t ws_size, hipStream_t stream) {
  Params p{};
  p.x = (const float*)d_in[0]; p.pos = (const int*)d_in[1];
  p.mixer_g = (const float*)d_in[2]; p.mlp_g = (const float*)d_in[3]; p.w1 = (const float*)d_in[4]; p.w2 = (const float*)d_in[5]; p.final_g = (const float*)d_in[6];
  p.ev_w_in = (const float*)d_in[7]; p.ev_conv_w = (const float*)d_in[8]; p.q_norm_g = (const float*)d_in[9]; p.w_uq = (const float*)d_in[10];
  p.kv_norm_g = (const float*)d_in[11]; p.w_ukv = (const float*)d_in[12]; p.ev_w_out = (const float*)d_in[13];
  p.od_w_in = (const float*)d_in[14]; p.gate_up = (const float*)d_in[15]; p.gate_b = (const float*)d_in[16]; p.gla_norm_g = (const float*)d_in[17];
  p.lru_conv_w = (const float*)d_in[18]; p.lru_conv_b = (const float*)d_in[19]; p.lru_w_a = (const float*)d_in[20]; p.lru_b_a = (const float*)d_in[21];
  p.lru_w_i = (const float*)d_in[22]; p.lru_b_i = (const float*)d_in[23]; p.lru_lam = (const float*)d_in[24]; p.od_w_out = (const float*)d_in[25];
  p.out = (float*)d_out; p.ws = (char*)d_ws;
  if (ws_size < WS_NEED) { fprintf(stderr, "workspace too small: %zu < %zu\n", ws_size, (size_t)WS_NEED); return; }
  static int grid_blocks = 0;
  if (!grid_blocks) {
    int dev = 0, cus = 0, per_cu = 0;
    hipGetDevice(&dev);
    hipDeviceGetAttribute(&cus, hipDeviceAttributeMultiprocessorCount, dev);
    hipOccupancyMaxActiveBlocksPerMultiprocessor(&per_cu, fwd_megakernel, 512, 0);
    if (per_cu < 1) per_cu = 1;
    if (per_cu > 1) per_cu = 1;
    grid_blocks = cus * per_cu;
  }
  hipMemsetAsync(d_ws, 0, 16384, stream);
#if MK_MULTI
  for (int ph = 0; ph < N_PHASES; ++ph) fwd_megakernel<<<dim3(grid_blocks), dim3(512), 0, stream>>>(p, ph, ph + 1, -1);
#else
  int lo = 0, hi = N_PHASES, probe_ph = PROBE_PH;
  void* args[] = {&p, &lo, &hi, &probe_ph};
  hipError_t e = hipLaunchCooperativeKernel((void*)fwd_megakernel, dim3(grid_blocks), dim3(512), args, 0, stream);
  if (e != hipSuccess) fprintf(stderr, "cooperative launch failed: %s (grid %d)\n", hipGetErrorString(e), grid_blocks);
#endif
}
```

```cpp
#include <hip/hip_runtime.h>
#include <hip/hip_cooperative_groups.h>
#include <stdint.h>
#include <stdio.h>
namespace cg = cooperative_groups;

#ifndef MK_MULTI
#define MK_MULTI 0
#endif

typedef unsigned short bf16_t;
typedef short bf16x8 __attribute__((ext_vector_type(8)));
typedef short s16x4 __attribute__((ext_vector_type(4)));
typedef float f32x4 __attribute__((ext_vector_type(4)));
typedef float f32x2 __attribute__((ext_vector_type(2)));
typedef float f32x16 __attribute__((ext_vector_type(16)));
typedef unsigned u32x4 __attribute__((ext_vector_type(4)));
typedef unsigned u32x2 __attribute__((ext_vector_type(2)));
typedef __bf16 bf16x2_t __attribute__((ext_vector_type(2)));

#define DI __device__ __forceinline__
#ifndef PH_MASK
#define PH_MASK 0xffff
#endif
#define PHM(k) ((PH_MASK >> (k)) & 1)
#ifndef PROBE_STEP
#define PROBE_STEP -1
#endif
#ifndef PROBE_PH
#define PROBE_PH -1
#endif
__device__ __forceinline__ int tidx() { int t = threadIdx.x; asm volatile("" : "+v"(t)); return t; }

constexpr int T = 32768, S = 4096, NB = 8;
constexpr size_t MB = 1u << 20;
constexpr size_t OFF_W1T = 1 * MB, OFF_W2T = 33 * MB, OFF_EWIN = 65 * MB, OFF_WUQ = 74 * MB, OFF_WUKV = 76 * MB, OFF_EWOUT = 77 * MB,
                 OFF_OWIN = 81 * MB, OFF_OWOUT = 92 * MB, OFF_HB = 96 * MB, OFF_SSQH = 160 * MB, OFF_SSQQ = 162 * MB, OFF_SSQKV = 163 * MB,
                 OFF_R = 164 * MB, WS_NEED = 502 * MB, OFF_LRUW = 65536;
constexpr size_t R_PROJ = 0, R_Q = 144 * MB, R_KF = 192 * MB, R_V = 240 * MB, R_MIX = 272 * MB;
constexpr size_t R_LOGA = 160 * MB, R_STATES = 192 * MB, R_DECAY = 256 * MB, R_LRUA = 257 * MB, R_LRUB = 258 * MB, R_LRUH = 259 * MB;
constexpr int EV_LD = 2304, OD_LD = 2560, HID_LD = 4096 + 128;

struct Params {
  const float* x; const int* pos;
  const float *mixer_g, *mlp_g, *w1, *w2, *final_g;
  const float *ev_w_in, *ev_conv_w, *q_norm_g, *w_uq, *kv_norm_g, *w_ukv, *ev_w_out;
  const float *od_w_in, *gate_up, *gate_b, *gla_norm_g, *lru_conv_w, *lru_conv_b, *lru_w_a, *lru_b_a, *lru_w_i, *lru_b_i, *lru_lam, *od_w_out;
  float* out; char* ws;
};

__shared__ __attribute__((aligned(1024))) char g_shm[132 * 1024];

DI unsigned pk2(float a, float b) { f32x2 v = {a, b}; bf16x2_t r = __builtin_convertvector(v, bf16x2_t); return __builtin_bit_cast(unsigned, r); }
DI bf16_t f2bf(float a) { return (bf16_t)(pk2(a, 0.f) & 0xffffu); }
DI float bf2f(bf16_t v) { return __uint_as_float(((unsigned)v) << 16); }
DI float bflo(unsigned u) { return __uint_as_float(u << 16); }
DI float bfhi(unsigned u) { return __uint_as_float(u & 0xffff0000u); }
DI int crow(int reg, int h) { return (reg & 3) + 8 * (reg >> 2) + 4 * h; }
#define MFMA32(a, b, c) __builtin_amdgcn_mfma_f32_32x32x16_bf16((a), (b), (c), 0, 0, 0)
#define MFMA16(a, b, c) __builtin_amdgcn_mfma_f32_16x16x32_bf16((a), (b), (c), 0, 0, 0)
#define WAIT_V0() asm volatile("s_waitcnt vmcnt(0)" ::: "memory")
DI bf16x8 pack8(const f32x16& x, int s) {
  u32x4 p;
  p.x = pk2(x[8 * s + 0], x[8 * s + 1]); p.y = pk2(x[8 * s + 2], x[8 * s + 3]);
  p.z = pk2(x[8 * s + 4], x[8 * s + 5]); p.w = pk2(x[8 * s + 6], x[8 * s + 7]);
  return __builtin_bit_cast(bf16x8, p);
}
DI float fexp(float x) { return __builtin_amdgcn_exp2f(x * 1.4426950408889634f); }
DI float frcp(float x) { return __builtin_amdgcn_rcpf(x); }
DI float sigmoidf_(float x) { return frcp(1.f + fexp(-x)); }


#define XB_TMO      128
#define XB_XCNT(j)  (256  + 64 * (j))
#define XB_XSUB(j)  (1280 + 64 * (j))
#define XB_XGEN(j)  (2304 + 64 * (j))
#define XB_TOP      3328
#define XB_TOPGEN   3392
#define XCD_BAR_WORDS 3456
#define XB_SPIN_CAP (1u << 22)
#define LAS __attribute__((address_space(3)))
DI unsigned xb_ld(unsigned* p)              { return __hip_atomic_load(p, __ATOMIC_RELAXED, __HIP_MEMORY_SCOPE_AGENT); }
DI unsigned xb_add(unsigned* p, unsigned v) { return __hip_atomic_fetch_add(p, v, __ATOMIC_RELAXED, __HIP_MEMORY_SCOPE_AGENT); }
DI unsigned xb_xcc_id() { return (unsigned)__builtin_amdgcn_s_getreg((3 << 11) | 20) & 0xFu; }
#define XB_SPIN(cond, bar) do { unsigned _sp = 0; while (cond) { __builtin_amdgcn_s_sleep(1); \
    if ((++_sp & 255u) == 0u) { if (xb_ld(&(bar)[XB_TMO])) break; if (_sp > XB_SPIN_CAP) { atomicAdd(&(bar)[XB_TMO], 1u); break; } } } } while (0)
struct XcdBarrier { unsigned* bar; unsigned x; volatile LAS unsigned* st; };
DI XcdBarrier xcd_barrier_post(unsigned* bar, volatile LAS unsigned* st) {
  XcdBarrier b; b.bar = bar; b.x = xb_xcc_id(); b.st = st;
  if (threadIdx.x == 0) (void)xb_add(&bar[XB_XCNT(b.x)], 1u);
  return b;
}
DI void xcd_barrier_complete(unsigned* bar, unsigned x, unsigned& nloc, unsigned& nx) {
  const unsigned G = gridDim.x * gridDim.y * gridDim.z;
  unsigned sum, cnt, mine, sp = 0u;
  for (;;) {
    sum = 0u; cnt = 0u; mine = 0u;
#pragma unroll
    for (unsigned j = 0; j < 16; ++j) { const unsigned c = xb_ld(&bar[XB_XCNT(j)]); sum += c; cnt += (c > 0u) ? 1u : 0u; mine = (j == x) ? c : mine; }
    if (sum == G) break;
    __builtin_amdgcn_s_sleep(1);
    if ((++sp & 255u) == 0u) { if (xb_ld(&bar[XB_TMO])) break; if (sp > XB_SPIN_CAP) { atomicAdd(&bar[XB_TMO], 1u); break; } }
  }
  nloc = mine > 0u ? mine : 1u; nx = cnt > 0u ? cnt : 1u;
}
DI void xcd_barrier(const XcdBarrier& b) {
  asm volatile("s_waitcnt vmcnt(0)" ::: "memory");
  __syncthreads();
  if (threadIdx.x == 0) {
    unsigned* bar = b.bar;
    __builtin_amdgcn_s_waitcnt(0);
    unsigned nloc = b.st[0], nx = b.st[1];
    if (nloc == 0u) { xcd_barrier_complete(bar, b.x, nloc, nx); b.st[0] = nloc; b.st[1] = nx; }
    const unsigned old = xb_add(&bar[XB_XSUB(b.x)], 1u);
    const unsigned gen = old / nloc;
    if (old + 1u == (gen + 1u) * nloc) {
      __builtin_amdgcn_fence(__ATOMIC_RELEASE, "agent");
      asm volatile("s_waitcnt vmcnt(0)" ::: "memory");
      const unsigned og = xb_add(&bar[XB_TOP], 1u);
      const unsigned tg = og / nx;
      if (og + 1u == (tg + 1u) * nx) xb_add(&bar[XB_TOPGEN], 1u);
      else XB_SPIN(xb_ld(&bar[XB_TOPGEN]) == tg, bar);
      __builtin_amdgcn_fence(__ATOMIC_ACQUIRE, "agent");
      xb_add(&bar[XB_XGEN(b.x)], 1u);
      asm volatile("s_waitcnt vmcnt(0)" ::: "memory");
    } else {
      XB_SPIN(xb_ld(&bar[XB_XGEN(b.x)]) == gen, bar);
      __builtin_amdgcn_fence(__ATOMIC_ACQUIRE, "agent");
      asm volatile("s_waitcnt vmcnt(0)" ::: "memory");
    }
  }
  __syncthreads();
}
constexpr int XB_LDS_OFF = 133120;

DI void zero_f32(float* p, int n) {
  for (int i = blockIdx.x * blockDim.x + tidx(); i < n; i += gridDim.x * blockDim.x) p[i] = 0.f;
}
DI int map_col(int mode, int n) {
  if (mode == 0) return n;
  if (mode == 1) { if (n < 1536) return n; if (n < 1792) return 1920 + (n - 1536); if (n < 2176) return 1536 + (n - 1792); if (n < 2208) { const int pp = n - 2176; return 2176 + 16 * ((pp >> 2) & 1) + 4 * (pp >> 3) + (pp & 3); } return -1; }
  if (mode == 2) { if (n < 512) return (n >> 6) * 128 + (n & 63); int m = n - 512; return (m >> 6) * 128 + 64 + (m & 63); }
  if (mode == 4) { const int h = n / 96, w = n % 96; if (w < 64) return n; const int pp = w - 64; return h * 96 + 64 + 16 * ((pp >> 2) & 1) + 4 * (pp >> 3) + (pp & 3); }
    if (n < 1024) return n; if (n < 2560) return n + 16; return -2 - (n - 2560);
}
struct PrepJob { const float* W; int K, N; bf16_t* dst; int Npad; const float* gain; int mode; const float* aux; };
DI PrepJob prep_get(const Params& p, int id) {
  char* ws = p.ws; PrepJob jb{};
  if (id < 4) { const int l = id; jb.W = p.w1 + (long)l * 1024 * 4096; jb.K = 1024; jb.N = 4096; jb.dst = (bf16_t*)(ws + OFF_W1T) + (long)l * 4096 * 1024; jb.Npad = 4096; jb.gain = p.mlp_g + l * 1024; jb.mode = 0; }
  else if (id < 8) { const int l = id - 4; jb.W = p.w2 + (long)l * 4096 * 1024; jb.K = 4096; jb.N = 1024; jb.dst = (bf16_t*)(ws + OFF_W2T) + (long)l * 4096 * 1024; jb.Npad = 1024; jb.gain = nullptr; jb.mode = 0; }
  else if (id >= 20) {
    const int q = id - 20, gate = q >> 4, jj = (q >> 3) & 1, blk = q & 7;
    jb.W = (gate ? p.lru_w_i : p.lru_w_a) + (long)(jj * 8 + blk) * 4096; jb.K = 64; jb.N = 64; jb.dst = (bf16_t*)(ws + OFF_LRUW) + (long)q * 4096; jb.Npad = 64; jb.gain = nullptr; jb.mode = 0;
  } else {
    const int j = (id - 8) / 6, t = (id - 8) % 6;
    if (t == 0) { jb.W = p.ev_w_in + (long)j * 1024 * 2208; jb.K = 1024; jb.N = 2208; jb.dst = (bf16_t*)(ws + OFF_EWIN) + (long)j * 2304 * 1024; jb.Npad = 2304; jb.gain = p.mixer_g + (2 * j) * 1024; jb.mode = 1; }
    else if (t == 1) { jb.W = p.w_uq + (long)j * 384 * 768; jb.K = 384; jb.N = 768; jb.dst = (bf16_t*)(ws + OFF_WUQ) + (long)j * 768 * 384; jb.Npad = 768; jb.gain = p.q_norm_g + j * 384; jb.mode = 4; }
    else if (t == 2) { jb.W = p.w_ukv + (long)j * 256 * 1024; jb.K = 256; jb.N = 1024; jb.dst = (bf16_t*)(ws + OFF_WUKV) + (long)j * 1024 * 256; jb.Npad = 1024; jb.gain = p.kv_norm_g + j * 256; jb.mode = 2; }
    else if (t == 3) { jb.W = p.ev_w_out + (long)j * 1024 * 1024; jb.K = 1024; jb.N = 1024; jb.dst = (bf16_t*)(ws + OFF_EWOUT) + (long)j * 1024 * 1024; jb.Npad = 1024; jb.gain = nullptr; jb.mode = 0; }
    else if (t == 4) { jb.W = p.od_w_in + (long)j * 1024 * 2576; jb.K = 1024; jb.N = 2576; jb.dst = (bf16_t*)(ws + OFF_OWIN) + (long)j * 2816 * 1024; jb.Npad = 2816; jb.gain = p.mixer_g + (2 * j + 1) * 1024; jb.mode = 3; jb.aux = p.gate_up + j * 16 * 256; }
    else { jb.W = p.od_w_out + (long)j * 1024 * 1024; jb.K = 1024; jb.N = 1024; jb.dst = (bf16_t*)(ws + OFF_OWOUT) + (long)j * 1024 * 1024; jb.Npad = 1024; jb.gain = nullptr; jb.mode = 0; }
  }
  return jb;
}
DI void prep_load(const PrepJob& jb, int tile, int ntn, bool fast, float (&rg)[16]) {
  const int tid = tidx();
  const float* __restrict__ W = jb.W; const int N = jb.N;
  const int k0 = (tile / ntn) * 64, n0 = (tile % ntn) * 128;
  if (fast) {
#pragma unroll
    for (int q = 0; q < 4; ++q) {
      const int i = tid + 512 * q, row = i >> 5, c4 = i & 31;
      f32x4 v = *(const f32x4*)(W + (long)(k0 + row) * N + n0 + c4 * 4);
      if (jb.gain) v = v * jb.gain[k0 + row];
      rg[4 * q] = v[0]; rg[4 * q + 1] = v[1]; rg[4 * q + 2] = v[2]; rg[4 * q + 3] = v[3];
    }
  } else {
    const int nl = tid & 127, src = map_col(jb.mode, n0 + nl);
#pragma unroll
    for (int q = 0; q < 16; ++q) {
      const int row = (tid >> 7) + 4 * q, k = k0 + row;
      float w;
      if (src >= 0) w = W[(long)k * N + src];
      else if (src == -1) w = 0.f;
      else { const int cc = -2 - src; float sm = 0.f; for (int r = 0; r < 16; ++r) sm += W[(long)k * N + 1024 + r] * jb.aux[r * 256 + cc]; w = sm; }
      if (jb.gain) w *= jb.gain[k];
      rg[q] = w;
    }
  }
}
DI int prep_ntiles(const PrepJob& jb) { return (jb.K / 64) * (jb.Npad / 128); }
DI PrepJob prep_find(const Params& p, int gt, int& lt) {
  PrepJob jb = prep_get(p, 0);
  for (int id = 0; id < 20; ++id) {
    jb = prep_get(p, id);
    const int n = prep_ntiles(jb);
    if (gt < n) break;
    gt -= n;
  }
  lt = gt; return jb;
}
DI void phase_prep(const Params& p) {
  char* ws = p.ws;
  {
    float* tl = (float*)g_shm;
    const int tid = tidx();
    int total = 0;
    for (int id = 0; id < 20; ++id) total += prep_ntiles(prep_get(p, id));
    int gt = blockIdx.x, lt = 0;
    float rg[16];
    PrepJob jb = prep_get(p, 0);
    if (gt < total) { jb = prep_find(p, gt, lt); prep_load(jb, lt, jb.Npad / 128, jb.mode == 0 && jb.N == jb.Npad, rg); }
    while (gt < total) {
      const int K = jb.K, ntn = jb.Npad / 128;
      const bool fast = (jb.mode == 0 && jb.N == jb.Npad);
      const int k0 = (lt / ntn) * 64, n0 = (lt % ntn) * 128;
      bf16_t* dst = jb.dst;
      __syncthreads();
      if (fast) {
#pragma unroll
        for (int q = 0; q < 4; ++q) {
          const int i = tid + 512 * q, row = i >> 5, c4 = i & 31;
          float* d = tl + row * 129 + c4 * 4;
          d[0] = rg[4 * q]; d[1] = rg[4 * q + 1]; d[2] = rg[4 * q + 2]; d[3] = rg[4 * q + 3];
        }
      } else {
#pragma unroll
        for (int q = 0; q < 16; ++q) tl[((tid >> 7) + 4 * q) * 129 + (tid & 127)] = rg[q];
      }
      __syncthreads();
      gt += gridDim.x;
      if (gt < total) { jb = prep_find(p, gt, lt); prep_load(jb, lt, jb.Npad / 128, jb.mode == 0 && jb.N == jb.Npad, rg); }
#pragma unroll
      for (int q = 0; q < 2; ++q) {
        const int o = tid + 512 * q, n = o >> 3, kc = o & 7;
        const float* sp = tl + (kc * 8) * 129 + n;
        u32x4 w;
        w.x = pk2(sp[0], sp[129]); w.y = pk2(sp[2 * 129], sp[3 * 129]); w.z = pk2(sp[4 * 129], sp[5 * 129]); w.w = pk2(sp[6 * 129], sp[7 * 129]);
        *(u32x4*)(dst + (long)(n0 + n) * K + k0 + kc * 8) = w;
      }
    }
  }
  {
    for (int c = blockIdx.x * blockDim.x + tidx(); c < 32 * 512; c += gridDim.x * blockDim.x) {
      const int q = c >> 9, w9 = c & 511, gate = q >> 4, jj = (q >> 3) & 1, blk = q & 7;
      const float* W = (gate ? p.lru_w_i : p.lru_w_a) + (long)(jj * 8 + blk) * 4096;
      bf16_t* dst = (bf16_t*)(ws + OFF_LRUW) + (long)q * 4096;
      const int n = w9 & 63, k0 = (w9 >> 6) * 8;
      float v[8];
#pragma unroll
      for (int e = 0; e < 8; ++e) v[e] = W[(k0 + e) * 64 + n];
      u32x4 o; o.x = pk2(v[0], v[1]); o.y = pk2(v[2], v[3]); o.z = pk2(v[4], v[5]); o.w = pk2(v[6], v[7]);
      *(u32x4*)(dst + n * 64 + k0) = o;
    }
  }
  bf16_t* hb = (bf16_t*)(ws + OFF_HB);
  float* ssq = (float*)(ws + OFF_SSQH);
  const int lane = tidx() & 63, gw = (blockIdx.x * blockDim.x + tidx()) >> 6, nw = (gridDim.x * blockDim.x) >> 6;
  for (int row0 = gw; row0 < T; row0 += 4 * nw) {
    f32x4 v[4][4];
#pragma unroll
    for (int k = 0; k < 4; ++k) {
      const int row = row0 + k * nw;
      if (row < T) {
#pragma unroll
        for (int i = 0; i < 4; ++i) v[k][i] = *(const f32x4*)(p.x + (long)row * 1024 + i * 256 + lane * 4);
      }
    }
#pragma unroll
    for (int k = 0; k < 4; ++k) {
      const int row = row0 + k * nw;
      if (row < T) {
        float ss = 0.f;
#pragma unroll
        for (int i = 0; i < 4; ++i) {
          ss += v[k][i][0] * v[k][i][0] + v[k][i][1] * v[k][i][1] + v[k][i][2] * v[k][i][2] + v[k][i][3] * v[k][i][3];
          u32x2 o; o.x = pk2(v[k][i][0], v[k][i][1]); o.y = pk2(v[k][i][2], v[k][i][3]);
          *(u32x2*)(hb + (long)row * 1024 + i * 256 + lane * 4) = o;
        }
#pragma unroll
        for (int d = 1; d < 64; d <<= 1) ss += __shfl_xor(ss, d);
        if (lane < 16) ssq[(long)row * 16 + lane] = (lane == 0) ? ss : 0.f;
      }
    }
  }
}

namespace pg8 {
constexpr int BM = 256, BK = 64, HALF = 128, HTB = HALF * BK * 2, STAGE_BYTES = 8 * HTB, NXCD = 8, WGM = 8;
DI int lds_byte(int r, int c) { const int st = (r >> 4) * 2 + (c >> 5), rr = r & 15, cc = c & 31, ob = rr * 64 + cc * 2; return st * 1024 + (ob ^ (((ob >> 9) & 1) << 5)); }
DI void stage_rc(int b, int& R, int& C) { const int st = b / 1024, sb = b % 1024, swz = sb ^ (((sb >> 9) & 1) << 5); R = (st >> 1) * 16 + swz / 64; C = (st & 1) * 32 + (swz % 64) / 2; }
DI int perm32(int rho) { const int n = rho >> 4, i = rho & 15; return 8 * (i >> 2) + 4 * n + (i & 3); }
struct Unit { int pm, pn; };
struct Gemm { const bf16_t* A; const bf16_t* Bt; int lda, K, nN; };
struct StaticOrder {
  int nM, nN, nwg, G, c;
  DI void init(int M, int nN_, int G_, int c_) { nM = M / BM; nN = nN_; nwg = nM * nN; G = G_; c = c_; }
  DI bool next(int i, Unit& u) const {
    const long L = (long)i * G + c; if (L >= nwg) return false;
    int wgid = (int)L; { const int q = nwg / NXCD, r = nwg % NXCD, xcd = wgid % NXCD, off = wgid / NXCD; wgid = (xcd < r ? xcd * (q + 1) : r * (q + 1) + (xcd - r) * q) + off; }
    const int nig = WGM * nN, gid = wgid / nig, fm = gid * WGM, gsz = (nM - fm) < WGM ? (nM - fm) : WGM;
    u.pm = fm + ((wgid % nig) % gsz); u.pn = (wgid % nig) / gsz; return true;
  }
};

template <class Epi, bool ALIGN_EPI = true>
DI void gemm_phase(const Gemm g, const StaticOrder& S, const Epi& E) {
  LAS unsigned char* lds = (LAS unsigned char*)g_shm;
  const int tid = tidx(), wid = __builtin_amdgcn_readfirstlane(tid >> 6), lane = tid & 63, wr = wid >> 2, wc = wid & 3, fr = lane & 15, fq = lane >> 4;
  const int K = g.K, nt = K / BK, lda = g.lda;
  unsigned voffA[2], voffB[2];
#pragma unroll
  for (int i = 0; i < 2; ++i) { int R, C; stage_rc(tid * 16 + i * 8192, R, C); const int Rb = (R & ~31) + perm32(R & 31);
    voffA[i] = (unsigned)(R * lda + C) * 2u; voffB[i] = (unsigned)(Rb * K + C) * 2u; }
  const size_t kstep = (size_t)(BK * 2);
  const size_t hstepA = (size_t)HALF * lda * 2, hstepB = (size_t)HALF * K * 2;
  const size_t tstepA = 2 * hstepA, tstepB = 2 * hstepB;
  const unsigned ldsw = (unsigned)wid * 1024u;
  const int aoff = lds_byte(wr * 64 + fr, fq * 8), boff = lds_byte(wc * 32 + fr, fq * 8);
#define PG8_SA(b, h) (((b) * 2 + (h)) * HTB)
#define PG8_SB(b, h) ((4 + (b) * 2 + (h)) * HTB)
#define PG8_STAGE(bufoff, gbase, voff) do { _Pragma("unroll") for (int _i = 0; _i < 2; ++_i) \
    __builtin_amdgcn_global_load_lds((const unsigned*)((const char*)(gbase) + (voff)[_i]), (LAS unsigned*)(lds + (bufoff) + ldsw + _i * 8192), 16, 0, 0); } while (0)
#define PG8_LDA(dst, b, h) do { _Pragma("unroll") for (int m = 0; m < 4; ++m) _Pragma("unroll") for (int k = 0; k < 2; ++k) dst[m][k] = *(const LAS bf16x8*)(lds + PG8_SA(b, h) + aoff + m * 2048 + k * 1024); } while (0)
#define PG8_LDB(dst, b, h) do { _Pragma("unroll") for (int n = 0; n < 2; ++n) _Pragma("unroll") for (int k = 0; k < 2; ++k) dst[n][k] = *(const LAS bf16x8*)(lds + PG8_SB(b, h) + boff + n * 2048 + k * 1024); } while (0)
#define PG8_MMA(ai, bj, At, Bt) do { __builtin_amdgcn_s_setprio(1); _Pragma("unroll") for (int m = 0; m < 4; ++m) _Pragma("unroll") for (int n = 0; n < 2; ++n) _Pragma("unroll") for (int k = 0; k < 2; ++k) \
    acc[ai][bj][m][n] = __builtin_amdgcn_mfma_f32_16x16x32_bf16(Bt[n][k], At[m][k], acc[ai][bj][m][n], 0, 0, 0); __builtin_amdgcn_s_setprio(0); } while (0)
#define PG8_WAIT_V(n) asm volatile("s_waitcnt vmcnt(" #n ")" ::: "memory")
#define PG8_WAIT_L(n) asm volatile("s_waitcnt lgkmcnt(" #n ")" ::: "memory")
#define PG8_BAR __builtin_amdgcn_s_barrier()
#define PG8_SCHED __builtin_amdgcn_sched_barrier(0)
  __syncthreads();
  Unit cur, nxt; int ui = 0;
  if (!S.next(0, cur)) return;
  f32x4 acc[2][2][4][2];
#pragma unroll
  for (int a = 0; a < 2; ++a)
#pragma unroll
    for (int b = 0; b < 2; ++b)
#pragma unroll
      for (int m = 0; m < 4; ++m)
#pragma unroll
        for (int n = 0; n < 2; ++n) acc[a][b][m][n] = (f32x4){0.f, 0.f, 0.f, 0.f};
  bf16x8 At[4][2], B0[2][2], B1[2][2];
  const char* cA = (const char*)g.A + (size_t)cur.pm * tstepA; const char* cB = (const char*)g.Bt + (size_t)cur.pn * tstepB;
  PG8_STAGE(PG8_SB(0, 0), cB, voffB); PG8_STAGE(PG8_SB(0, 1), cB + hstepB, voffB); PG8_STAGE(PG8_SA(0, 0), cA, voffA); PG8_STAGE(PG8_SA(0, 1), cA + hstepA, voffA);
  if (wr == 1) PG8_BAR;
  PG8_WAIT_V(2); PG8_BAR;
  PG8_STAGE(PG8_SB(1, 0), cB + kstep, voffB); PG8_STAGE(PG8_SA(1, 0), cA + kstep, voffA); PG8_STAGE(PG8_SB(1, 1), cB + hstepB + kstep, voffB);
  PG8_WAIT_V(6); PG8_BAR;
  for (;;) {
    const bool has_next = S.next(ui + 1, nxt);
    const char* nA = has_next ? (const char*)g.A + (size_t)nxt.pm * tstepA : cA; const char* nB = has_next ? (const char*)g.Bt + (size_t)nxt.pn * tstepB : cB;
#pragma nounroll
    for (int t = 0; t < nt; t += 2) {
      const bool last = (t == nt - 2);
      const char* a1 = cA + (size_t)(t + 1) * kstep;
      const char* a2 = last ? nA : cA + (size_t)(t + 2) * kstep; const char* b2 = last ? nB : cB + (size_t)(t + 2) * kstep;
      const char* a3 = a2 + kstep; const char* b3 = b2 + kstep;
      PG8_LDB(B0, 0, 0); PG8_LDB(B1, 0, 1); PG8_SCHED; PG8_LDA(At, 0, 0); PG8_STAGE(PG8_SA(1, 1), a1 + hstepA, voffA);
      PG8_WAIT_V(8); PG8_WAIT_L(0); PG8_BAR; PG8_MMA(0, 0, At, B0); PG8_MMA(0, 1, At, B1); PG8_BAR; PG8_SCHED;
      PG8_LDA(At, 0, 1); PG8_STAGE(PG8_SB(0, 0), b2, voffB); PG8_STAGE(PG8_SB(0, 1), b2 + hstepB, voffB); PG8_STAGE(PG8_SA(0, 0), a2, voffA);
      PG8_WAIT_V(8); PG8_WAIT_L(0); PG8_BAR; PG8_MMA(1, 0, At, B0); PG8_MMA(1, 1, At, B1); PG8_BAR; PG8_SCHED;
      PG8_LDB(B0, 1, 0); PG8_LDB(B1, 1, 1); PG8_SCHED; PG8_LDA(At, 1, 0); PG8_STAGE(PG8_SA(0, 1), a2 + hstepA, voffA);
      PG8_WAIT_V(8); PG8_WAIT_L(0); PG8_BAR; PG8_MMA(0, 0, At, B0); PG8_MMA(0, 1, At, B1); PG8_BAR; PG8_SCHED;
      PG8_LDA(At, 1, 1); PG8_STAGE(PG8_SB(1, 0), b3, voffB); PG8_STAGE(PG8_SB(1, 1), b3 + hstepB, voffB); PG8_STAGE(PG8_SA(1, 0), a3, voffA);
      PG8_WAIT_V(8); PG8_WAIT_L(0); PG8_BAR; PG8_MMA(1, 0, At, B0); PG8_MMA(1, 1, At, B1); PG8_BAR; PG8_SCHED;
    }
    if constexpr (ALIGN_EPI) { if (wr == 0) PG8_BAR; }
    E(acc, cur, wr, wc, fr, fq);
    if (!has_next) break;
#pragma unroll
    for (int a = 0; a < 2; ++a)
#pragma unroll
      for (int b = 0; b < 2; ++b)
#pragma unroll
        for (int m = 0; m < 4; ++m)
#pragma unroll
          for (int n = 0; n < 2; ++n) acc[a][b][m][n] = (f32x4){0.f, 0.f, 0.f, 0.f};
    cur = nxt; cA = nA; cB = nB; ++ui;
    if constexpr (ALIGN_EPI) { if (wr == 1) PG8_BAR; }
  }
  PG8_WAIT_V(0);
  if constexpr (!ALIGN_EPI) { if (wr == 0) PG8_BAR; }
  PG8_BAR;
#undef PG8_SA
#undef PG8_SB
#undef PG8_STAGE
#undef PG8_LDA
#undef PG8_LDB
#undef PG8_MMA
#undef PG8_WAIT_V
#undef PG8_WAIT_L
#undef PG8_BAR
#undef PG8_SCHED
}
}

DI void rope_ang(float pos, int i, float& sn, float& cs) {
  const float inv_freq = __builtin_amdgcn_exp2f(-(float)i * (13.287712379549449f / 16.f));
  const float ang = pos * inv_freq;
  float tr = ang * 0.15915494309189535f; tr -= rintf(tr);
  sn = __builtin_amdgcn_sinf(tr); cs = __builtin_amdgcn_cosf(tr);
}
DI u32x4 pack8v(const f32x4& a, const f32x4& b) { return (u32x4){pk2(a[0], a[1]), pk2(a[2], a[3]), pk2(b[0], b[1]), pk2(b[2], b[3])}; }
typedef f32x4 AccT[2][2][4][2];
#define EPI_ROWLOOP _Pragma("unroll") for (int ai = 0; ai < 2; ++ai) _Pragma("unroll") for (int m = 0; m < 4; ++m)
#define EPI_ROW (long)u.pm * 256 + ai * 128 + wr * 64 + m * 16 + fr

struct EpiResid {
  bf16_t* hb; float* ssq;
  DI void operator()(const AccT& acc, const pg8::Unit& u, int wr, int wc, int fr, int fq) const {
    EPI_ROWLOOP {
      const long row = EPI_ROW;
      float ss = 0.f;
#pragma unroll
      for (int bj = 0; bj < 2; ++bj) {
        bf16_t* hp = hb + row * 1024 + u.pn * 256 + bj * 128 + wc * 32 + fq * 8;
        const u32x4 r = *(const u32x4*)hp;
        f32x4 a = acc[ai][bj][m][0], b = acc[ai][bj][m][1];
        a[0] += bflo(r[0]); a[1] += bfhi(r[0]); a[2] += bflo(r[1]); a[3] += bfhi(r[1]);
        b[0] += bflo(r[2]); b[1] += bfhi(r[2]); b[2] += bflo(r[3]); b[3] += bfhi(r[3]);
        *(u32x4*)hp = pack8v(a, b);
        ss += a[0] * a[0] + a[1] * a[1] + a[2] * a[2] + a[3] * a[3] + b[0] * b[0] + b[1] * b[1] + b[2] * b[2] + b[3] * b[3];
      }
      ss += __shfl_xor(ss, 16); ss += __shfl_xor(ss, 32);
      if (fq == 0) ssq[row * 16 + u.pn * 4 + wc] = ss;
    }
  }
};
struct EpiMlp1 {
  bf16_t* hid; const float* ssq;
  DI void operator()(const AccT& acc, const pg8::Unit& u, int wr, int wc, int fr, int fq) const {
    EPI_ROWLOOP {
      const long row = EPI_ROW;
      float rs; { const f32x4 pv = *(const f32x4*)(ssq + row * 16 + fq * 4); float t = (pv[0] + pv[1]) + (pv[2] + pv[3]); t += __shfl_xor(t, 16); t += __shfl_xor(t, 32); rs = rsqrtf(t * (1.f / 1024.f) + 1e-6f); }
#pragma unroll
      for (int bj = 0; bj < 2; ++bj) {
        f32x4 a = acc[ai][bj][m][0] * rs, b = acc[ai][bj][m][1] * rs;
#pragma unroll
        for (int j = 0; j < 4; ++j) { const float x = fmaxf(a[j], 0.f), y = fmaxf(b[j], 0.f); a[j] = x * x; b[j] = y * y; }
        __builtin_nontemporal_store(pack8v(a, b), (u32x4*)(hid + row * HID_LD + u.pn * 256 + bj * 128 + wc * 32 + fq * 8));
      }
    }
  }
};
struct EpiProjEven {
  bf16_t* proj; const float* ssq; float* ssq_kv; float* ssq_q; bf16_t* kf; const int* pos;
  DI void operator()(const AccT& acc, const pg8::Unit& u, int wr, int wc, int fr, int fq) const {
    EPI_ROWLOOP {
      const long row = EPI_ROW;
      float rs; { const f32x4 pv = *(const f32x4*)(ssq + row * 16 + fq * 4); float t = (pv[0] + pv[1]) + (pv[2] + pv[3]); t += __shfl_xor(t, 16); t += __shfl_xor(t, 32); rs = rsqrtf(t * (1.f / 1024.f) + 1e-6f); }
      float ssb[2];
#pragma unroll
      for (int bj = 0; bj < 2; ++bj) {
        const f32x4 a = acc[ai][bj][m][0] * rs, b = acc[ai][bj][m][1] * rs;
        *(u32x4*)(proj + row * EV_LD + u.pn * 256 + bj * 128 + wc * 32 + fq * 8) = pack8v(a, b);
        ssb[bj] = a[0] * a[0] + a[1] * a[1] + a[2] * a[2] + a[3] * a[3] + b[0] * b[0] + b[1] * b[1] + b[2] * b[2] + b[3] * b[3];
        if (bj == 1 && u.pn == 8 && wc == 0) {
          const float ps = (float)pos[row];
          f32x4 o1, o2;
#pragma unroll
          for (int j = 0; j < 4; ++j) { float sn, cs; rope_ang(ps, fq * 4 + j, sn, cs); o1[j] = a[j] * cs - b[j] * sn; o2[j] = b[j] * cs + a[j] * sn; }
          u32x2 w1, w2; w1.x = pk2(o1[0], o1[1]); w1.y = pk2(o1[2], o1[3]); w2.x = pk2(o2[0], o2[1]); w2.y = pk2(o2[2], o2[3]);
          const int bb = (int)(row / S), s = (int)(row % S);
#pragma unroll
          for (int h = 0; h < 8; ++h) { bf16_t* d = kf + ((long)(bb * 8 + h) * S + s) * 96 + 64 + fq * 4; *(u32x2*)d = w1; *(u32x2*)(d + 16) = w2; }
        }
      }
      if (u.pn >= 6) {
        float ss = (u.pn == 8) ? ssb[0] : ssb[0] + ssb[1];
        ss += __shfl_xor(ss, 16); ss += __shfl_xor(ss, 32);
        if (fq == 0) { if (u.pn == 6) ssq_kv[row * 4 + wc] = ss; else ssq_q[row * 8 + (u.pn - 7) * 4 + wc] = ss; }
      }
    }
  }
};
struct EpiQ {
  bf16_t* q; const float* ssq; const int* pos;
  DI void operator()(const AccT& acc, const pg8::Unit& u, int wr, int wc, int fr, int fq) const {
    const float QS = 0.10206207261596575f * 1.4426950408889634f;
    EPI_ROWLOOP {
      const long row = EPI_ROW;
      float rs; { const f32x2 pv = *(const f32x2*)(ssq + row * 8 + fq * 2); float t = pv[0] + pv[1]; t += __shfl_xor(t, 16); t += __shfl_xor(t, 32); rs = rsqrtf(t * (1.f / 384.f) + 1e-6f) * QS; }
#pragma unroll
      for (int bj = 0; bj < 2; ++bj) {
        const int c0 = u.pn * 256 + bj * 128 + wc * 32;
        const f32x4 a = acc[ai][bj][m][0] * rs, b = acc[ai][bj][m][1] * rs;
        if ((c0 % 96) == 64) {
          const float ps = (float)pos[row];
          f32x4 o1, o2;
#pragma unroll
          for (int j = 0; j < 4; ++j) { float sn, cs; rope_ang(ps, fq * 4 + j, sn, cs); o1[j] = a[j] * cs - b[j] * sn; o2[j] = b[j] * cs + a[j] * sn; }
          u32x2 w1, w2; w1.x = pk2(o1[0], o1[1]); w1.y = pk2(o1[2], o1[3]); w2.x = pk2(o2[0], o2[1]); w2.y = pk2(o2[2], o2[3]);
          bf16_t* d = q + row * 768 + c0 + fq * 4; *(u32x2*)d = w1; *(u32x2*)(d + 16) = w2;
        } else {
          *(u32x4*)(q + row * 768 + c0 + fq * 8) = pack8v(a, b);
        }
      }
      __builtin_amdgcn_sched_barrier(0);
    }
  }
};
struct EpiKV {
  bf16_t* kf; bf16_t* vv; const float* ssq;
  DI void operator()(const AccT& acc, const pg8::Unit& u, int wr, int wc, int fr, int fq) const {
    EPI_ROWLOOP {
      const long row = EPI_ROW;
      float rs; { float t = ssq[row * 4 + fq]; t += __shfl_xor(t, 16); t += __shfl_xor(t, 32); rs = rsqrtf(t * (1.f / 256.f) + 1e-6f); }
      const int bb = (int)(row / S), s = (int)(row % S);
#pragma unroll
      for (int bj = 0; bj < 2; ++bj) {
        const int kcol = (u.pn & 1) * 256 + bj * 128 + wc * 32 + fq * 8, h = kcol >> 6, d = kcol & 63;
        const f32x4 a = acc[ai][bj][m][0] * rs, b = acc[ai][bj][m][1] * rs;
        bf16_t* dst = (u.pn < 2) ? (kf + ((long)(bb * 8 + h) * S + s) * 96 + d) : (vv + ((long)(bb * 8 + h) * S + s) * 64 + d);
        *(u32x4*)dst = pack8v(a, b);
      }
      __builtin_amdgcn_sched_barrier(0);
    }
  }
};
struct EpiProjOdd {
  bf16_t* proj; float* loga; const float* gb; const float* ssq;
  DI void operator()(const AccT& acc, const pg8::Unit& u, int wr, int wc, int fr, int fq) const {
    EPI_ROWLOOP {
      const long row = EPI_ROW;
      float rs; { const f32x4 pv = *(const f32x4*)(ssq + row * 16 + fq * 4); float t = (pv[0] + pv[1]) + (pv[2] + pv[3]); t += __shfl_xor(t, 16); t += __shfl_xor(t, 32); rs = rsqrtf(t * (1.f / 1024.f) + 1e-6f); }
#pragma unroll
      for (int bj = 0; bj < 2; ++bj) {
        const int cl = bj * 128 + wc * 32 + fq * 8;
        f32x4 a = acc[ai][bj][m][0] * rs, b = acc[ai][bj][m][1] * rs;
        if (u.pn < 10) {
          *(u32x4*)(proj + row * OD_LD + u.pn * 256 + cl) = pack8v(a, b);
        } else {
          const f32x4 g0 = *(const f32x4*)(gb + cl), g1 = *(const f32x4*)(gb + cl + 4);
#pragma unroll
          for (int j = 0; j < 4; ++j) {
            const float z0 = a[j] + g0[j], z1 = b[j] + g1[j];
            a[j] = (fminf(z0, 0.f) - 0.6931471805599453f * __builtin_amdgcn_logf(1.f + fexp(-fabsf(z0)))) * 0.0625f;
            b[j] = (fminf(z1, 0.f) - 0.6931471805599453f * __builtin_amdgcn_logf(1.f + fexp(-fabsf(z1)))) * 0.0625f;
          }
          *(f32x4*)(loga + row * 256 + cl) = a; *(f32x4*)(loga + row * 256 + cl + 4) = b;
        }
      }
      __builtin_amdgcn_sched_barrier(0);
    }
  }
};
template <class Epi>
DI void run_gemm(const bf16_t* A, int lda, const bf16_t* Bt, int K, int nN, const Epi& E) {
  pg8::Gemm g; g.A = A; g.Bt = Bt; g.lda = lda; g.K = K; g.nN = nN;
  pg8::StaticOrder S; S.init(T, nN, gridDim.x, blockIdx.x);
  pg8::gemm_phase<Epi, true>(g, S, E);
}

DI void conv_even(const bf16_t* __restrict__ proj, const float* __restrict__ cw, bf16_t* __restrict__ mix) {
  for (long it = (long)blockIdx.x * blockDim.x + tidx(); it < (long)T * 64; it += (long)gridDim.x * blockDim.x) {
    const long tok = it >> 6; const int c8 = (int)(it & 63) * 8; const int s = (int)(tok % S);
    const bf16_t* pr = proj + tok * EV_LD;
    const u32x4 gb = *(const u32x4*)(pr + c8);
    float accv[8];
#pragma unroll
    for (int e = 0; e < 8; ++e) accv[e] = 0.f;
#pragma unroll
    for (int k = 0; k < 3; ++k) {
      const int back = 2 - k;
      if (s >= back) {
        const u32x4 gc = *(const u32x4*)(pr - (long)back * EV_LD + 512 + c8);
        const u32x4 uu = *(const u32x4*)(pr - (long)back * EV_LD + 1024 + c8);
        const f32x4 w0 = *(const f32x4*)(cw + k * 512 + c8), w1 = *(const f32x4*)(cw + k * 512 + c8 + 4);
#pragma unroll
        for (int e = 0; e < 4; ++e) {
          accv[2 * e] += (e < 2 ? w0[2 * e] : w1[2 * e - 4]) * bflo(gc[e]) * bflo(uu[e]);
          accv[2 * e + 1] += (e < 2 ? w0[2 * e + 1] : w1[2 * e - 3]) * bfhi(gc[e]) * bfhi(uu[e]);
        }
      }
    }
    u32x4 o;
#pragma unroll
    for (int e = 0; e < 4; ++e) o[e] = pk2(accv[2 * e] * bflo(gb[e]), accv[2 * e + 1] * bfhi(gb[e]));
    *(u32x4*)(mix + tok * 1024 + c8) = o;
  }
}

constexpr int AT_KSTR = 208, AT_VSTR = 264, AT_KBUF = 128 * AT_KSTR, AT_VBUF = 64 * AT_VSTR, AT_VOFF = 2 * AT_KBUF;
DI void attn_qtile(const bf16_t* __restrict__ q, const bf16_t* __restrict__ kf, const bf16_t* __restrict__ vv, bf16_t* __restrict__ mix, int b, int h, int qt) {
  const int tid = tidx(), wid = __builtin_amdgcn_readfirstlane(tid >> 6), lane = tid & 63, r = lane & 31, hh = lane >> 5;
  const int q0 = qt * 256;
  const int qrow = q0 + wid * 32 + r;
  const int wave_qmin = q0 + wid * 32, wave_qmax = wave_qmin + 31;
  const long bh = (long)b * 8 + h;
  bf16x8 qf[6];
  {
    const bf16_t* qp = q + ((long)b * S + qrow) * 768 + h * 96 + hh * 8;
#pragma unroll
    for (int ks = 0; ks < 6; ++ks) qf[ks] = *(const bf16x8*)(qp + ks * 16);
  }
  f32x16 o0, o1;
#pragma unroll
  for (int i = 0; i < 16; ++i) { o0[i] = 0.f; o1[i] = 0.f; }
  float mrun = 0.f, lrun = 0.f;
  f32x16 negm;
#pragma unroll
  for (int i = 0; i < 16; ++i) negm[i] = 0.f;
  const int nkt = (q0 + 256) / 128;
  const bf16_t* kbase = kf + bh * S * 96;
  const bf16_t* vbase = vv + bh * S * 64;
  const int vkey = tid & 127, vdc = tid >> 7;
  u32x4 kr[3], vr[2];
  __syncthreads();
#define AT_LOAD(k0) do { \
    const bf16_t* kb_ = kbase + (long)(k0) * 96; \
    _Pragma("unroll") for (int i_ = 0; i_ < 3; ++i_) kr[i_] = *(const u32x4*)(kb_ + (long)(tid + 512 * i_) * 8); \
    _Pragma("unroll") for (int i_ = 0; i_ < 2; ++i_) vr[i_] = *(const u32x4*)(vbase + (long)((k0) + vkey) * 64 + (vdc + 4 * i_) * 8); } while (0)
#define AT_WRITE(buf) do { \
    _Pragma("unroll") for (int i_ = 0; i_ < 3; ++i_) { const int c = tid + 512 * i_; *(u32x4*)(g_shm + (buf) * AT_KBUF + (c / 12) * AT_KSTR + (c % 12) * 16) = kr[i_]; } \
    _Pragma("unroll") for (int i_ = 0; i_ < 2; ++i_) { char* vb = g_shm + AT_VOFF + (buf) * AT_VBUF + ((vdc + 4 * i_) * 8) * AT_VSTR + vkey * 2; \
      _Pragma("unroll") for (int e = 0; e < 4; ++e) { \
        *(bf16_t*)(vb + (2 * e) * AT_VSTR) = (bf16_t)(vr[i_][e] & 0xffffu); \
        *(bf16_t*)(vb + (2 * e + 1) * AT_VSTR) = (bf16_t)(vr[i_][e] >> 16); } } } while (0)
  AT_LOAD(0);
  AT_WRITE(0);
  __syncthreads();
  for (int kt = 0; kt < nkt; ++kt) {
    if (kt + 1 < nkt) AT_LOAD((kt + 1) * 128);
#pragma unroll
    for (int sb = 0; sb < 2; ++sb) {
      const int k0 = kt * 128 + sb * 64;
      if (k0 <= wave_qmax) {
        const char* Kb = g_shm + (kt & 1) * AT_KBUF + (sb * 64 + r) * AT_KSTR + hh * 16;
        const char* Vb = g_shm + AT_VOFF + (kt & 1) * AT_VBUF + r * AT_VSTR + sb * 128 + hh * 8;
        f32x16 s0, s1;
#pragma unroll
        for (int ks = 0; ks < 6; ++ks) {
          const bf16x8 a0 = *(const bf16x8*)(Kb + ks * 32);
          const bf16x8 a1 = *(const bf16x8*)(Kb + 32 * AT_KSTR + ks * 32);
          s0 = MFMA32(a0, qf[ks], ks == 0 ? negm : s0);
          s1 = MFMA32(a1, qf[ks], ks == 0 ? negm : s1);
        }
        if (k0 + 63 > wave_qmin) {
#pragma unroll
          for (int i = 0; i < 16; ++i) {
            const int key = k0 + crow(i, hh);
            if (key > qrow) s0[i] = -INFINITY;
            if (key + 32 > qrow) s1[i] = -INFINITY;
          }
        }
        float la0 = 0.f, la1 = 0.f, la2 = 0.f, la3 = 0.f;
#pragma unroll
        for (int i = 0; i < 16; i += 2) {
          s0[i] = __builtin_amdgcn_exp2f(s0[i]); s0[i + 1] = __builtin_amdgcn_exp2f(s0[i + 1]);
          s1[i] = __builtin_amdgcn_exp2f(s1[i]); s1[i + 1] = __builtin_amdgcn_exp2f(s1[i + 1]);
          la0 += s0[i]; la1 += s0[i + 1]; la2 += s1[i]; la3 += s1[i + 1];
        }
        const float ls = (la0 + la1) + (la2 + la3);
        lrun += ls;
        bf16x8 pb[2][2];
        pb[0][0] = pack8(s0, 0); pb[0][1] = pack8(s0, 1); pb[1][0] = pack8(s1, 0); pb[1][1] = pack8(s1, 1);
#pragma unroll
        for (int kb = 0; kb < 2; ++kb)
#pragma unroll
          for (int s2 = 0; s2 < 2; ++s2) {
            const int kofs = (32 * kb + 16 * s2) * 2;
            const s16x4 lo0 = *(const s16x4*)(Vb + kofs), hi0 = *(const s16x4*)(Vb + kofs + 16);
            const s16x4 lo1 = *(const s16x4*)(Vb + 32 * AT_VSTR + kofs), hi1 = *(const s16x4*)(Vb + 32 * AT_VSTR + kofs + 16);
            const bf16x8 va0 = __builtin_shufflevector(lo0, hi0, 0, 1, 2, 3, 4, 5, 6, 7);
            const bf16x8 va1 = __builtin_shufflevector(lo1, hi1, 0, 1, 2, 3, 4, 5, 6, 7);
            o0 = MFMA32(va0, pb[kb][s2], o0);
            o1 = MFMA32(va1, pb[kb][s2], o1);
          }
        if (__any(ls > 4096.f)) {
          const float big = fmaxf(ls, __shfl_xor(ls, 32));
          const float delta = (big > 4096.f) ? floorf(__builtin_amdgcn_logf(big)) : 0.f;
          const float alpha = __builtin_amdgcn_exp2f(-delta);
          lrun *= alpha; mrun += delta;
#pragma unroll
          for (int i = 0; i < 16; ++i) { o0[i] *= alpha; o1[i] *= alpha; negm[i] = -mrun; }
        }
      }
    }
    if (kt + 1 < nkt) AT_WRITE((kt + 1) & 1);
    __syncthreads();
  }
#undef AT_WRITE
#undef AT_LOAD
  const float ltot = lrun + __shfl_xor(lrun, 32);
  const float inv = 1.f / ltot;
  bf16_t* op = mix + ((long)b * S + qrow) * 1024 + 512 + h * 64;
#pragma unroll
  for (int g4 = 0; g4 < 4; ++g4) {
    const int dv = 8 * g4 + 4 * hh;
    u32x2 a, c;
    a.x = pk2(o0[4 * g4] * inv, o0[4 * g4 + 1] * inv); a.y = pk2(o0[4 * g4 + 2] * inv, o0[4 * g4 + 3] * inv);
    c.x = pk2(o1[4 * g4] * inv, o1[4 * g4 + 1] * inv); c.y = pk2(o1[4 * g4 + 2] * inv, o1[4 * g4 + 3] * inv);
    *(u32x2*)(op + dv) = a; *(u32x2*)(op + 32 + dv) = c;
  }
}
DI void phase_attn(const bf16_t* q, const bf16_t* kf, const bf16_t* vv, bf16_t* mix) {
  for (int u = blockIdx.x; u < 512; u += gridDim.x) {
    const int xcd = u & 7, idx = u >> 3, bhh = (idx >> 3) * 8 + xcd, pi = idx & 7;
    const int b = bhh >> 3, h = bhh & 7;
    attn_qtile(q, kf, vv, mix, b, h, 15 - pi);
    attn_qtile(q, kf, vv, mix, b, h, pi);
  }
}

constexpr int GL_STR = 144;
DI float gla_cum(const float* __restrict__ loga, long t0, int hd, float (&cum)[8]) {
  const int tid = tidx(), dk = tid & 63, seg = tid >> 6;
  float* segs = (float*)g_shm;
#pragma unroll
  for (int e = 0; e < 8; ++e) cum[e] = loga[(t0 + seg * 8 + e) * 256 + hd * 64 + dk];
#pragma unroll
  for (int e = 1; e < 8; ++e) cum[e] += cum[e - 1];
  segs[seg * 64 + dk] = cum[7];
  __syncthreads();
  float off = 0.f, tot = 0.f;
#pragma unroll
  for (int s = 0; s < 8; ++s) { const float v = segs[s * 64 + dk]; tot += v; if (s < seg) off += v; }
#pragma unroll
  for (int e = 0; e < 8; ++e) cum[e] += off;
  return tot;
}
DI void gla_stage_vT(const bf16_t* __restrict__ proj, long t0, int hd, char* vT) {
  const int tid = tidx(), dv = tid & 127, jq = tid >> 7;
  unsigned w[8];
#pragma unroll
  for (int e = 0; e < 8; ++e) {
    const unsigned a = proj[(t0 + jq * 16 + 2 * e) * OD_LD + 512 + hd * 128 + dv];
    const unsigned b = proj[(t0 + jq * 16 + 2 * e + 1) * OD_LD + 512 + hd * 128 + dv];
    w[e] = a | (b << 16);
  }
  *(u32x4*)(vT + dv * GL_STR + jq * 32) = (u32x4){w[0], w[1], w[2], w[3]};
  *(u32x4*)(vT + dv * GL_STR + jq * 32 + 16) = (u32x4){w[4], w[5], w[6], w[7]};
}
DI void gla_g1_unit(const bf16_t* __restrict__ proj, const float* __restrict__ loga, float* __restrict__ states, float* __restrict__ decay, int unit) {
  const int tid = tidx(), wid = tid >> 6, lane = tid & 63, r = lane & 31, hh = lane >> 5, dk = tid & 63, seg = tid >> 6;
  const int n = unit & 63, hd = (unit >> 6) & 3, b = unit >> 8;
  const long t0 = (long)b * S + n * 64;
  char* koT = g_shm + 2048; char* vT = g_shm + 11264;
  __syncthreads();
  float cum[8];
  const float tot = gla_cum(loga, t0, hd, cum);
  {
    float ko[8];
#pragma unroll
    for (int e = 0; e < 8; ++e) ko[e] = bf2f(proj[(t0 + seg * 8 + e) * OD_LD + 256 + hd * 64 + dk]) * fexp(tot - cum[e]);
    u32x4 o; o.x = pk2(ko[0], ko[1]); o.y = pk2(ko[2], ko[3]); o.z = pk2(ko[4], ko[5]); o.w = pk2(ko[6], ko[7]);
    *(u32x4*)(koT + dk * GL_STR + seg * 16) = o;
    if (seg == 0) decay[(long)unit * 64 + dk] = fexp(tot);
  }
  gla_stage_vT(proj, t0, hd, vT);
  __syncthreads();
  const int dvb = wid >> 1, dkb = wid & 1;
  f32x16 acc;
#pragma unroll
  for (int i = 0; i < 16; ++i) acc[i] = 0.f;
#pragma unroll
  for (int ks = 0; ks < 4; ++ks) {
    const bf16x8 a = *(const bf16x8*)(vT + (32 * dvb + r) * GL_STR + ks * 32 + hh * 16);
    const bf16x8 bb = *(const bf16x8*)(koT + (32 * dkb + r) * GL_STR + ks * 32 + hh * 16);
    acc = MFMA32(a, bb, acc);
  }
  float* st = states + (long)unit * 8192;
#pragma unroll
  for (int i = 0; i < 16; ++i) st[(32 * dvb + crow(i, hh)) * 64 + 32 * dkb + r] = acc[i];
}
DI void gla_g3_unit(const bf16_t* __restrict__ proj, const float* __restrict__ loga, const float* __restrict__ states, const float* __restrict__ gng,
                    bf16_t* __restrict__ mix, int unit) {
  const int tid = tidx(), wid = tid >> 6, lane = tid & 63, r = lane & 31, hh = lane >> 5, dk = tid & 63, seg = tid >> 6;
  const int n = unit & 63, hd = (unit >> 6) & 3, b = unit >> 8;
  const long t0 = (long)b * S + n * 64;
  char* qin = g_shm + 2048; char* kin = g_shm + 11264; char* vT = g_shm + 20480; char* sT = g_shm + 38912; float* ssp = (float*)(g_shm + 57344);
  __syncthreads();
  float cum[8];
  (void)gla_cum(loga, t0, hd, cum);
#pragma unroll
  for (int e = 0; e < 8; ++e) {
    const int tok = seg * 8 + e;
    const float qv = bf2f(proj[(t0 + tok) * OD_LD + hd * 64 + dk]) * 0.125f * fexp(cum[e]);
    const float kv = bf2f(proj[(t0 + tok) * OD_LD + 256 + hd * 64 + dk]) * fexp(-cum[e]);
    *(bf16_t*)(qin + tok * GL_STR + dk * 2) = f2bf(qv);
    *(bf16_t*)(kin + tok * GL_STR + dk * 2) = f2bf(kv);
  }
  gla_stage_vT(proj, t0, hd, vT);
  {
    const int dv = tid >> 2, dq = tid & 3;
    const float* sp = states + (long)unit * 8192 + dv * 64 + dq * 16;
    const f32x4 a = *(const f32x4*)sp, c = *(const f32x4*)(sp + 4), d = *(const f32x4*)(sp + 8), f = *(const f32x4*)(sp + 12);
    *(u32x4*)(sT + dv * GL_STR + dq * 32) = (u32x4){pk2(a[0], a[1]), pk2(a[2], a[3]), pk2(c[0], c[1]), pk2(c[2], c[3])};
    *(u32x4*)(sT + dv * GL_STR + dq * 32 + 16) = (u32x4){pk2(d[0], d[1]), pk2(d[2], d[3]), pk2(f[0], f[1]), pk2(f[2], f[3])};
  }
  __syncthreads();
  const int ib = wid >> 2, dvb = wid & 3;
  f32x16 o;
#pragma unroll
  for (int i = 0; i < 16; ++i) o[i] = 0.f;
  bf16x8 qfr[4];
#pragma unroll
  for (int ks = 0; ks < 4; ++ks) qfr[ks] = *(const bf16x8*)(qin + (32 * ib + r) * GL_STR + ks * 32 + hh * 16);
#pragma unroll
  for (int ks = 0; ks < 4; ++ks) {
    const bf16x8 a = *(const bf16x8*)(sT + (32 * dvb + r) * GL_STR + ks * 32 + hh * 16);
    o = MFMA32(a, qfr[ks], o);
  }
#pragma unroll
  for (int jb = 0; jb < 2; ++jb) {
    if (jb <= ib) {
      f32x16 at;
#pragma unroll
      for (int i = 0; i < 16; ++i) at[i] = 0.f;
#pragma unroll
      for (int ks = 0; ks < 4; ++ks) {
        const bf16x8 a = *(const bf16x8*)(kin + (32 * jb + r) * GL_STR + ks * 32 + hh * 16);
        at = MFMA32(a, qfr[ks], at);
      }
      if (jb == ib) {
#pragma unroll
        for (int i = 0; i < 16; ++i) if (crow(i, hh) > r) at[i] = 0.f;
      }
      const bf16x8 p0 = pack8(at, 0), p1 = pack8(at, 1);
      {
        const char* vb = vT + (32 * dvb + r) * GL_STR + (32 * jb + 4 * hh) * 2;
        const s16x4 lo0 = *(const s16x4*)(vb), hi0 = *(const s16x4*)(vb + 16);
        const s16x4 lo1 = *(const s16x4*)(vb + 32), hi1 = *(const s16x4*)(vb + 48);
        o = MFMA32(__builtin_shufflevector(lo0, hi0, 0, 1, 2, 3, 4, 5, 6, 7), p0, o);
        o = MFMA32(__builtin_shufflevector(lo1, hi1, 0, 1, 2, 3, 4, 5, 6, 7), p1, o);
      }
    }
  }
  float ss = 0.f;
#pragma unroll
  for (int i = 0; i < 16; ++i) ss += o[i] * o[i];
  ss += __shfl_xor(ss, 32);
  if (hh == 0) ssp[(32 * ib + r) * 4 + dvb] = ss;
  __syncthreads();
  const f32x4 pp = *(const f32x4*)(ssp + (32 * ib + r) * 4);
  const float rs = rsqrtf((pp[0] + pp[1] + pp[2] + pp[3]) * (1.f / 128.f) + 1e-6f);
  const long tok = t0 + 32 * ib + r;
#pragma unroll
  for (int g4 = 0; g4 < 4; ++g4) {
    const int dv = 32 * dvb + 8 * g4 + 4 * hh;
    const u32x2 gt = *(const u32x2*)(proj + tok * OD_LD + 1024 + hd * 128 + dv);
    const f32x4 gn = *(const f32x4*)(gng + dv);
    float gv[4] = {bflo(gt.x), bfhi(gt.x), bflo(gt.y), bfhi(gt.y)};
    float ov[4];
#pragma unroll
    for (int e = 0; e < 4; ++e) ov[e] = o[4 * g4 + e] * rs * gn[e] * (gv[e] * sigmoidf_(gv[e]));
    u32x2 w; w.x = pk2(ov[0], ov[1]); w.y = pk2(ov[2], ov[3]);
    *(u32x2*)(mix + tok * 1024 + hd * 128 + dv) = w;
  }
}
constexpr int LX_STR = 1040;
DI void lru_g1_unit(const Params& p, int j, const bf16_t* __restrict__ proj, bf16_t* __restrict__ hl, bf16_t* __restrict__ Pp, float* __restrict__ lruA,
                    float* __restrict__ lruB, const bf16_t* __restrict__ lw, int unit) {
  const int tid = tidx(), wid = tid >> 6, lane = tid & 63, r = lane & 31, hh = lane >> 5;
  const int n = unit & 63, b = unit >> 6;
  const long t0 = (long)b * S + n * 64;
  char* xraw = g_shm;
  char* xcb = g_shm;
  __syncthreads();
  {
    u32x4 v[9];
#pragma unroll
    for (int i = 0; i < 9; ++i) {
      const int q = tid + 512 * i, row = q >> 6, c16 = q & 63;
      v[i] = (u32x4){0u, 0u, 0u, 0u};
      if (row < 67 && (n > 0 || row >= 3)) v[i] = *(const u32x4*)(proj + (t0 - 3 + row) * OD_LD + 1536 + c16 * 8);
    }
#pragma unroll
    for (int i = 0; i < 9; ++i) {
      const int q = tid + 512 * i, row = q >> 6, c16 = q & 63;
      if (row < 67) *(u32x4*)(xraw + row * LX_STR + c16 * 16) = v[i];
    }
  }
  __syncthreads();
  {
    const int c = tid;
    const float* cw = p.lru_conv_w + j * 4 * 512;
    const float w0 = cw[c], w1 = cw[512 + c], w2 = cw[1024 + c], w3 = cw[1536 + c], cb = p.lru_conv_b[j * 512 + c];
    float xm3 = bf2f(*(const bf16_t*)(xraw + 0 * LX_STR + c * 2)), xm2 = bf2f(*(const bf16_t*)(xraw + 1 * LX_STR + c * 2)), xm1 = bf2f(*(const bf16_t*)(xraw + 2 * LX_STR + c * 2));
#pragma unroll 8
    for (int t = 0; t < 64; ++t) {
      const float xt = bf2f(*(const bf16_t*)(xraw + (t + 3) * LX_STR + c * 2));
      *(bf16_t*)(xcb + t * LX_STR + c * 2) = f2bf(cb + w0 * xm3 + w1 * xm2 + w2 * xm1 + w3 * xt);
      xm3 = xm2; xm2 = xm1; xm1 = xt;
    }
  }
  __syncthreads();
  const int blk = wid;
  char* otile = g_shm + 66560 + wid * 8192;
#pragma unroll 1
  for (int cbk = 0; cbk < 2; ++cbk) {
    const int c = blk * 64 + 32 * cbk + r;
    bf16x8 wfa[4], wfi[4];
    {
      const bf16_t* wa = lw + ((long)((0 * 2 + j) * 8 + blk) * 64 + 32 * cbk + r) * 64 + 8 * hh;
      const bf16_t* wi = lw + ((long)((1 * 2 + j) * 8 + blk) * 64 + 32 * cbk + r) * 64 + 8 * hh;
#pragma unroll
      for (int ks = 0; ks < 4; ++ks) { wfa[ks] = *(const bf16x8*)(wa + 16 * ks); wfi[ks] = *(const bf16x8*)(wi + 16 * ks); }
    }
    f32x16 aA[2], aI[2];
#pragma unroll
    for (int rb = 0; rb < 2; ++rb) {
#pragma unroll
      for (int i = 0; i < 16; ++i) { aA[rb][i] = 0.f; aI[rb][i] = 0.f; }
#pragma unroll
      for (int ks = 0; ks < 4; ++ks) {
        const bf16x8 A = *(const bf16x8*)(xcb + (32 * rb + r) * LX_STR + (blk * 64 + 16 * ks + 8 * hh) * 2);
        aA[rb] = MFMA32(A, wfa[ks], aA[rb]);
        aI[rb] = MFMA32(A, wfi[ks], aI[rb]);
      }
    }
    const float ba = p.lru_b_a[j * 512 + c], bi = p.lru_b_i[j * 512 + c];
    const float lam = p.lru_lam[j * 512 + c];
    const float sp = fmaxf(-lam, 0.f) + log1pf(__expf(-fabsf(lam)));
#pragma unroll
    for (int rb = 0; rb < 2; ++rb)
#pragma unroll
      for (int i = 0; i < 16; ++i) {
        const int tok = 32 * rb + crow(i, hh);
        const float xcv = bf2f(*(const bf16_t*)(xcb + tok * LX_STR + c * 2));
        const float rg = sigmoidf_(aA[rb][i] + ba), ig = sigmoidf_(aI[rb][i] + bi);
        const float la = -8.f * rg * sp;
        const float a = fexp(la);
        const float x2 = 2.f * la;
        const float om = (x2 > -0.25f) ? -x2 * (1.f + x2 * (0.5f + x2 * ((1.f / 6.f) + x2 * ((1.f / 24.f) + x2 * (1.f / 120.f))))) : 1.f - a * a;
        const float mult = __builtin_amdgcn_sqrtf(fmaxf(om, 0.f));
        aA[rb][i] = a; aI[rb][i] = mult * ig * xcv;
      }
    float gA[8], gB[8], oA[8], oB[8];
#pragma unroll
    for (int gi = 0; gi < 8; ++gi) {
      float A = 1.f, B = 0.f;
#pragma unroll
      for (int e = 0; e < 4; ++e) { const float a = aA[gi >> 2][4 * (gi & 3) + e], x = aI[gi >> 2][4 * (gi & 3) + e]; B = a * B + x; A *= a; }
      gA[gi] = A; gB[gi] = B;
      oA[gi] = __shfl_xor(A, 32); oB[gi] = __shfl_xor(B, 32);
    }
    float h = 0.f, P = 1.f, hs[8], Ps[8];
#pragma unroll
    for (int gi = 0; gi < 8; ++gi) {
      const float A0 = hh ? oA[gi] : gA[gi], B0 = hh ? oB[gi] : gB[gi];
      const float A1 = hh ? gA[gi] : oA[gi], B1 = hh ? gB[gi] : oB[gi];
      const float h1 = A0 * h + B0, P1 = P * A0;
      hs[gi] = hh ? h1 : h; Ps[gi] = hh ? P1 : P;
      h = A1 * h1 + B1; P = P1 * A1;
    }
#pragma unroll
    for (int gi = 0; gi < 8; ++gi) {
      float hc = hs[gi], Pc = Ps[gi];
#pragma unroll
      for (int e = 0; e < 4; ++e) {
        const float a = aA[gi >> 2][4 * (gi & 3) + e], x = aI[gi >> 2][4 * (gi & 3) + e];
        hc = a * hc + x; Pc *= a;
        const int tk = 32 * (gi >> 2) + 8 * (gi & 3) + 4 * hh + e;
        *(bf16_t*)(otile + tk * 64 + r * 2) = f2bf(hc); *(bf16_t*)(otile + 4096 + tk * 64 + r * 2) = f2bf(Pc);
      }
    }
    __builtin_amdgcn_wave_barrier(); asm volatile("s_waitcnt lgkmcnt(0)" ::: "memory");
#pragma unroll
    for (int i = 0; i < 8; ++i) {
      const int rw = (lane >> 2) + 16 * i, pc = lane & 3, arr = rw >> 6, tk = rw & 63;
      const u32x4 v = *(const u32x4*)(otile + rw * 64 + pc * 16);
      bf16_t* dst = (arr ? Pp : hl) + (t0 + tk) * 512 + blk * 64 + 32 * cbk + pc * 8;
      *(u32x4*)dst = v;
    }
    __builtin_amdgcn_wave_barrier(); asm volatile("s_waitcnt lgkmcnt(0)" ::: "memory");
    if (hh == 0) { lruA[(long)unit * 512 + c] = P; lruB[(long)unit * 512 + c] = h; }
  }
}
DI float gelu_tanh(float y) {
  const float u = 0.7978845608028654f * (y + 0.044715f * y * y * y);
  const float e = fexp(2.f * u);
  const float th = 1.f - 2.f * frcp(e + 1.f);
  return 0.5f * y * (1.f + th);
}
DI void lru_g3(const bf16_t* __restrict__ proj, const bf16_t* __restrict__ hl, const bf16_t* __restrict__ Pp, const float* __restrict__ hin, bf16_t* __restrict__ mix) {
  const long gstride = (long)gridDim.x * blockDim.x;
  for (long it0 = (long)blockIdx.x * blockDim.x + tidx(); it0 < (long)T * 64; it0 += 4 * gstride) {
    u32x4 y[4], hv[4], pv[4]; f32x4 h0[4], h1[4];
#pragma unroll
    for (int k = 0; k < 4; ++k) {
      const long it = it0 + k * gstride;
      if (it < (long)T * 64) {
        const long tok = it >> 6; const int c8 = (int)(it & 63) * 8;
        const int b = (int)(tok / S), n = (int)(tok % S) >> 6;
        y[k] = *(const u32x4*)(proj + tok * OD_LD + 2048 + c8);
        hv[k] = *(const u32x4*)(hl + tok * 512 + c8);
        pv[k] = *(const u32x4*)(Pp + tok * 512 + c8);
        const float* hp = hin + ((long)(b * 64 + n)) * 512 + c8;
        h0[k] = *(const f32x4*)hp; h1[k] = *(const f32x4*)(hp + 4);
      }
    }
#pragma unroll
    for (int k = 0; k < 4; ++k) {
      const long it = it0 + k * gstride;
      if (it < (long)T * 64) {
        const long tok = it >> 6; const int c8 = (int)(it & 63) * 8;
        u32x4 o;
#pragma unroll
        for (int e = 0; e < 4; ++e) {
          const float hi0 = (e < 2 ? h0[k][2 * e] : h1[k][2 * e - 4]), hi1 = (e < 2 ? h0[k][2 * e + 1] : h1[k][2 * e - 3]);
          const float a = gelu_tanh(bflo(y[k][e])) * (bflo(hv[k][e]) + bflo(pv[k][e]) * hi0);
          const float c = gelu_tanh(bfhi(y[k][e])) * (bfhi(hv[k][e]) + bfhi(pv[k][e]) * hi1);
          o[e] = pk2(a, c);
        }
        *(u32x4*)(mix + tok * 1024 + 512 + c8) = o;
      }
    }
  }
}
DI void phase_g2(float* __restrict__ states, const float* __restrict__ decay, const float* __restrict__ lruA, const float* __restrict__ lruB, float* __restrict__ hin) {
  const long gt = (long)blockIdx.x * blockDim.x + tidx(), gn = (long)gridDim.x * blockDim.x;
  for (long idx = gt; idx < 32L * 8192; idx += gn) {
    const int bhd = (int)(idx >> 13), e = (int)(idx & 8191), dk = e & 63;
    float s = 0.f;
    for (int n0 = 0; n0 < 64; n0 += 32) {
      float* ptr = states + ((long)(bhd * 64 + n0)) * 8192 + e;
      const float* dp = decay + (long)(bhd * 64 + n0) * 64 + dk;
      float v[32], d[32];
#pragma unroll
      for (int n = 0; n < 32; ++n) { v[n] = ptr[(long)n * 8192]; d[n] = dp[n * 64]; }
#pragma unroll
      for (int n = 0; n < 32; ++n) { const float tmp = v[n]; v[n] = s; s = d[n] * s + tmp; }
#pragma unroll
      for (int n = 0; n < 32; ++n) ptr[(long)n * 8192] = v[n];
    }
  }
  for (long idx = gt; idx < 8L * 512; idx += gn) {
    const int b = (int)(idx >> 9), c = (int)(idx & 511);
    float h = 0.f;
    for (int n0 = 0; n0 < 64; n0 += 32) {
      const long o0 = (long)(b * 64 + n0) * 512 + c;
      float av[32], bv[32];
#pragma unroll
      for (int n = 0; n < 32; ++n) { av[n] = lruA[o0 + (long)n * 512]; bv[n] = lruB[o0 + (long)n * 512]; }
#pragma unroll
      for (int n = 0; n < 32; ++n) { hin[o0 + (long)n * 512] = h; h = av[n] * h + bv[n]; }
    }
  }
}
DI void phase_final(const Params& p) {
  const int lane = tidx() & 63, gw = (blockIdx.x * blockDim.x + tidx()) >> 6, nw = (gridDim.x * blockDim.x) >> 6;
  const bf16_t* hb = (const bf16_t*)(p.ws + OFF_HB);
  for (int row = gw; row < T; row += nw) {
    const bf16_t* hr = hb + (long)row * 1024;
    float* xr = p.out + (long)row * 1024;
    float v[16]; float ss = 0.f;
#pragma unroll
    for (int i = 0; i < 2; ++i) {
      const u32x4 u = *(const u32x4*)(hr + i * 512 + lane * 8);
#pragma unroll
      for (int e = 0; e < 4; ++e) { v[i * 8 + 2 * e] = bflo(u[e]); v[i * 8 + 2 * e + 1] = bfhi(u[e]); }
    }
#pragma unroll
    for (int i = 0; i < 16; ++i) ss += v[i] * v[i];
#pragma unroll
    for (int d = 1; d < 64; d <<= 1) ss += __shfl_xor(ss, d);
    const float rs = rsqrtf(ss * (1.f / 1024.f) + 1e-6f);
#pragma unroll
    for (int i = 0; i < 2; ++i) {
      const f32x4 g0 = *(const f32x4*)(p.final_g + i * 512 + lane * 8), g1 = *(const f32x4*)(p.final_g + i * 512 + lane * 8 + 4);
      *(f32x4*)(xr + i * 512 + lane * 8) = (f32x4){v[i * 8] * rs * g0[0], v[i * 8 + 1] * rs * g0[1], v[i * 8 + 2] * rs * g0[2], v[i * 8 + 3] * rs * g0[3]};
      *(f32x4*)(xr + i * 512 + lane * 8 + 4) = (f32x4){v[i * 8 + 4] * rs * g1[0], v[i * 8 + 5] * rs * g1[1], v[i * 8 + 6] * rs * g1[2], v[i * 8 + 7] * rs * g1[3]};
    }
  }
}

constexpr int N_PHASES = 1 + 6 + 7 + 6 + 7 + 1;
DI void run_phase(const Params& p, int ph) {
  char* ws = p.ws; char* R = ws + OFF_R;
  bf16_t* hb = (bf16_t*)(ws + OFF_HB);
  float* ssqh = (float*)(ws + OFF_SSQH);
  bf16_t* mix = (bf16_t*)(R + R_MIX);
  if (ph == 0) { if (PHM(14)) for (int rp = 0; rp < (PROBE_STEP == 14 ? 2 : 1); ++rp) phase_prep(p); return; }
  if (ph == N_PHASES - 1) { if (PHM(15)) phase_final(p); return; }
  int q = ph - 1, layer = 0;
  while (true) { const int ns = (layer & 1) ? 7 : 6; if (q < ns) break; q -= ns; ++layer; }
  const int j = layer >> 1, odd = layer & 1;
  int step = q;
  if (odd && step >= 4) step -= 1; else if (odd) step += 10;
  const int reps = (step == PROBE_STEP) ? 2 : 1;
  float* H0 = (float*)(ws + OFF_SSQH); float* H1 = (float*)(ws + 500 * MB);
  float* ssqq = (float*)(ws + OFF_SSQQ); float* ssqkv = (float*)(ws + OFF_SSQKV);
  if (step == 0 && PHM(0)) {
    EpiProjEven E{(bf16_t*)(R + R_PROJ), H0, ssqkv, ssqq, (bf16_t*)(R + R_KF), p.pos};
    run_gemm(hb, 1024, (bf16_t*)(ws + OFF_EWIN) + (long)j * 2304 * 1024, 1024, 9, E);
  } else if (step == 1 && PHM(1)) {
    const bf16_t* proj = (bf16_t*)(R + R_PROJ);
    EpiQ Eq{(bf16_t*)(R + R_Q), ssqq, p.pos};
#ifndef NO_Q
    run_gemm(proj + 1792, EV_LD, (bf16_t*)(ws + OFF_WUQ) + (long)j * 768 * 384, 384, 3, Eq);
#endif
    EpiKV Ek{(bf16_t*)(R + R_KF), (bf16_t*)(R + R_V), ssqkv};
#ifndef NO_KV
    run_gemm(proj + 1536, EV_LD, (bf16_t*)(ws + OFF_WUKV) + (long)j * 1024 * 256, 256, 4, Ek);
#endif
    for (int rp = 0; rp < reps; ++rp) conv_even(proj, p.ev_conv_w + j * 3 * 512, mix);
  } else if (step == 2 && PHM(2)) {
    for (int rp = 0; rp < reps; ++rp) phase_attn((bf16_t*)(R + R_Q), (bf16_t*)(R + R_KF), (bf16_t*)(R + R_V), mix);
  } else if (step == 3 && PHM(3)) {
    EpiResid E{hb, H1};
    run_gemm(mix, 1024, (odd ? (bf16_t*)(ws + OFF_OWOUT) : (bf16_t*)(ws + OFF_EWOUT)) + (long)j * 1024 * 1024, 1024, 4, E);
  } else if (step == 4 && PHM(4)) {
    EpiMlp1 E{(bf16_t*)(R), H1};
    run_gemm(hb, 1024, (bf16_t*)(ws + OFF_W1T) + (long)layer * 4096 * 1024, 1024, 16, E);
  } else if (step == 5 && PHM(5)) {
    EpiResid E{hb, H0};
    run_gemm((bf16_t*)(R), HID_LD, (bf16_t*)(ws + OFF_W2T) + (long)layer * 4096 * 1024, 4096, 4, E);
  } else if (step == 10 && PHM(10)) {
    EpiProjOdd E{(bf16_t*)(R + R_PROJ), (float*)(R + R_LOGA), p.gate_b + j * 256, H0};
    run_gemm(hb, 1024, (bf16_t*)(ws + OFF_OWIN) + (long)j * 2816 * 1024, 1024, 11, E);
  } else if (step == 11 && PHM(11)) {
    const bf16_t* proj = (bf16_t*)(R + R_PROJ);
    for (int rp = 0; rp < reps; ++rp)
    for (int u = blockIdx.x; u < 512; u += gridDim.x)
      lru_g1_unit(p, j, proj, (bf16_t*)p.out, (bf16_t*)p.out + (long)T * 512, (float*)(R + R_LRUA), (float*)(R + R_LRUB), (const bf16_t*)(ws + OFF_LRUW), u);
    for (int rp = 0; rp < (PROBE_STEP == 21 ? 2 : 1); ++rp)
    for (int u = blockIdx.x; u < 2048; u += gridDim.x)
      gla_g1_unit(proj, (float*)(R + R_LOGA), (float*)(R + R_STATES), (float*)(R + R_DECAY), u);
  } else if (step == 12 && PHM(12)) {
    phase_g2((float*)(R + R_STATES), (float*)(R + R_DECAY), (float*)(R + R_LRUA), (float*)(R + R_LRUB), (float*)(R + R_LRUH));
  } else if (step == 13 && PHM(13)) {
    const bf16_t* proj = (bf16_t*)(R + R_PROJ);
    for (int rp = 0; rp < reps; ++rp)
    for (int u = blockIdx.x; u < 2048; u += gridDim.x)
      gla_g3_unit(proj, (float*)(R + R_LOGA), (float*)(R + R_STATES), p.gla_norm_g + j * 128, mix, u);
    lru_g3(proj, (bf16_t*)p.out, (bf16_t*)p.out + (long)T * 512, (float*)(R + R_LRUH), mix);
  }
}

__global__ void __launch_bounds__(512) fwd_megakernel(Params p, int lo, int hi, int probe_ph) {
  cg::grid_group grid = cg::this_grid();
  volatile LAS unsigned* st = (volatile LAS unsigned*)(LAS char*)(g_shm + XB_LDS_OFF);
  if (threadIdx.x == 0) { st[0] = 0u; st[1] = 0u; }
  __syncthreads();
  XcdBarrier xb = xcd_barrier_post((unsigned*)p.ws, st);
  for (int ph = lo; ph < hi; ++ph) {
    const int nrep = (ph == probe_ph) ? 2 : 1;
    for (int rp = 0; rp < nrep; ++rp) {
      if (rp) xcd_barrier(xb);
      run_phase(p, ph);
    }
    if (ph + 1 < hi) {
      if (hi > N_PHASES) grid.sync();
      else xcd_barrier(xb);
    }
  }
}

extern "C" void kernel_launch(void* const* d_in, const int* in_sizes, int n_in, void* d_out, int out_size, void* d_ws, size_t ws_size, hipStream_t stream) {
  Params p{};
  p.x = (const float*)d_in[0]; p.pos = (const int*)d_in[1];
  p.mixer_g = (const float*)d_in[2]; p.mlp_g = (const float*)d_in[3]; p.w1 = (const float*)d_in[4]; p.w2 = (const float*)d_in[5]; p.final_g = (const float*)d_in[6];
  p.ev_w_in = (const float*)d_in[7]; p.ev_conv_w = (const float*)d_in[8]; p.q_norm_g = (const float*)d_in[9]; p.w_uq = (const float*)d_in[10];
  p.kv_norm_g = (const float*)d_in[11]; p.w_ukv = (const float*)d_in[12]; p.ev_w_out = (const float*)d_in[13];
  p.od_w_in = (const float*)d_in[14]; p.gate_up = (const float*)d_in[15]; p.gate_b = (const float*)d_in[16]; p.gla_norm_g = (const float*)d_in[17];
  p.lru_conv_w = (const float*)d_in[18]; p.lru_conv_b = (const float*)d_in[19]; p.lru_w_a = (const float*)d_in[20]; p.lru_b_a = (const float*)d_in[21];
  p.lru_w_i = (const float*)d_in[22]; p.lru_b_i = (const float*)d_in[23]; p.lru_lam = (const float*)d_in[24]; p.od_w_out = (const float*)d_in[25];
  p.out = (float*)d_out; p.ws = (char*)d_ws;
  if (ws_size < WS_NEED) { fprintf(stderr, "workspace too small: %zu < %zu\n", ws_size, (size_t)WS_NEED); return; }
  static int grid_blocks = 0;
  if (!grid_blocks) {
    int dev = 0, cus = 0, per_cu = 0;
    hipGetDevice(&dev);
    hipDeviceGetAttribute(&cus, hipDeviceAttributeMultiprocessorCount, dev);
    hipOccupancyMaxActiveBlocksPerMultiprocessor(&per_cu, fwd_megakernel, 512, 0);
    if (per_cu < 1) per_cu = 1;
    if (per_cu > 1) per_cu = 1;
    grid_blocks = cus * per_cu;
  }
  hipMemsetAsync(d_ws, 0, 16384, stream);
#if MK_MULTI
  for (int ph = 0; ph < N_PHASES; ++ph) fwd_megakernel<<<dim3(grid_blocks), dim3(512), 0, stream>>>(p, ph, ph + 1, -1);
#else
  int lo = 0, hi = N_PHASES, probe_ph = PROBE_PH;
  void* args[] = {&p, &lo, &hi, &probe_ph};
  hipError_t e = hipLaunchCooperativeKernel((void*)fwd_megakernel, dim3(grid_blocks), dim3(512), args, 0, stream);
  if (e != hipSuccess) fprintf(stderr, "cooperative launch failed: %s (grid %d)\n", hipGetErrorString(e), grid_blocks);
#endif
}
```
